# Optimizing an MI355X kernel written in HIP

```python
import jax, jax.numpy as jnp
from jax import lax
import numpy as np

D_MODEL = 1024
BATCH = 4
SEQ = 4096
DEPTH = 1

N_META = 16
GRID_W = 64
HEAD_DIM = 64
N_DIR = 2
RWKV_HEADS = 8
RWKV_WIDTH = RWKV_HEADS * HEAD_DIM
DECAY_LORA = 64
ICL_LORA = 64
GATE_LORA = 160
LNX_EPS = 64e-5
ATTN_Q_HEADS = 8
ATTN_KV_HEADS = 2
ATTN_GROUP = ATTN_Q_HEADS // ATTN_KV_HEADS
ATTN_Q_WIDTH = ATTN_Q_HEADS * HEAD_DIM
ATTN_KV_WIDTH = ATTN_KV_HEADS * HEAD_DIM
Q_BLOCK = 128
ROPE_THETA = 10000.0
AXIS_DIM = HEAD_DIM // 2
AXIS_FREQS = AXIS_DIM // 2
D_FF = 4 * D_MODEL
NORM_EPS = 1e-6
RWKV_IN_WIDTH = 3 * RWKV_WIDTH + N_DIR * DECAY_LORA + N_DIR * ICL_LORA + GATE_LORA
IN_WIDTH = RWKV_IN_WIDTH + ATTN_Q_WIDTH + 2 * ATTN_KV_WIDTH + 2 * D_MODEL
IN_SPLITS = [RWKV_IN_WIDTH,
             RWKV_IN_WIDTH + ATTN_Q_WIDTH,
             RWKV_IN_WIDTH + ATTN_Q_WIDTH + ATTN_KV_WIDTH,
             RWKV_IN_WIDTH + ATTN_Q_WIDTH + 2 * ATTN_KV_WIDTH,
             RWKV_IN_WIDTH + ATTN_Q_WIDTH + 2 * ATTN_KV_WIDTH + D_MODEL]
RWKV_SPLITS = [RWKV_WIDTH, 2 * RWKV_WIDTH, 3 * RWKV_WIDTH,
               3 * RWKV_WIDTH + N_DIR * DECAY_LORA,
               3 * RWKV_WIDTH + N_DIR * DECAY_LORA + N_DIR * ICL_LORA]

kernel_name = "hybrid_rwkv7_axial_gqa_gated_encoder"


def rms_norm(x, g, eps=NORM_EPS):
    xf = x.astype(jnp.float32)
    y = xf * lax.rsqrt(jnp.mean(xf * xf, axis=-1, keepdims=True) + eps)
    return (y * g.astype(jnp.float32)).astype(x.dtype)


def centred_shift(p, mu):
    prev = jnp.pad(p[:, :-1], ((0, 0), (1, 0), (0, 0)))
    nxt = jnp.pad(p[:, 1:], ((0, 0), (0, 1), (0, 0)))
    return p + mu[0] * (prev - p) + mu[1] * (nxt - p)


def to_dirs(fwd, bwd):
    B, L, _ = fwd.shape
    t = jnp.stack([fwd, jnp.flip(bwd, axis=1)], axis=0).astype(jnp.float32)
    return t.reshape(N_DIR, B, L, RWKV_HEADS, HEAD_DIM).transpose(2, 0, 1, 3, 4)


def rwkv7_step(S, inp):
    r, w, k, v, kk, kka = inp
    sa = jnp.einsum('dbhij,dbhj->dbhi', S, -kk)
    S = S * w[..., None, :] + sa[..., :, None] * kka[..., None, :] + v[..., :, None] * k[..., None, :]
    y = jnp.einsum('dbhij,dbhj->dbhi', S, r)
    return S, y


def rwkv7_mixer(p, shift_mu, w0, w2, a0, a2, g2, k_k, k_a, r_k, lnx_g, lnx_b):
    B, L, _ = p.shape
    z = centred_shift(p, shift_mu)
    r, k, v, wd, ad, gd = jnp.split(z, RWKV_SPLITS, axis=-1)
    wd = wd.reshape(B, L, N_DIR, DECAY_LORA)
    ad = ad.reshape(B, L, N_DIR, ICL_LORA)
    w_log = -jax.nn.softplus(-(w0 + jnp.einsum('bldr,drc->bldc', jnp.tanh(wd), w2))) - 0.5
    decay = jnp.exp(-jnp.exp(w_log.astype(jnp.float32)))
    a = jax.nn.sigmoid(a0 + jnp.einsum('bldr,drc->bldc', ad, a2))
    g = jax.nn.sigmoid(gd) @ g2
    kk = (k * k_k).reshape(B, L, RWKV_HEADS, HEAD_DIM).astype(jnp.float32)
    kk = kk / jnp.maximum(jnp.linalg.norm(kk, axis=-1, keepdims=True), 1e-12)
    kk = kk.reshape(B, L, RWKV_WIDTH)
    k_dir = k[:, :, None, :] * (1.0 + (a - 1.0) * k_a)
    kka = kk[:, :, None, :] * a
    xs = (to_dirs(r, r), to_dirs(decay[:, :, 0], decay[:, :, 1]),
          to_dirs(k_dir[:, :, 0], k_dir[:, :, 1]), to_dirs(v, v), to_dirs(kk, kk),
          to_dirs(kka[:, :, 0], kka[:, :, 1]))
    S0 = jnp.zeros((N_DIR, B, RWKV_HEADS, HEAD_DIM, HEAD_DIM), jnp.float32)
    _, ys = lax.scan(rwkv7_step, S0, xs)
    ys = ys.transpose(1, 2, 0, 3, 4)
    y = ys[0] + jnp.flip(ys[1], axis=1)
    mu = jnp.mean(y, axis=-1, keepdims=True)
    var = jnp.mean(jnp.square(y - mu), axis=-1, keepdims=True)
    y = (y - mu) * lax.rsqrt(var + LNX_EPS)
    y = y * lnx_g.reshape(RWKV_HEADS, HEAD_DIM) + lnx_b.reshape(RWKV_HEADS, HEAD_DIM)
    rh = r.reshape(B, L, RWKV_HEADS, HEAD_DIM).astype(jnp.float32)
    kh = jnp.mean(k_dir, axis=2).reshape(B, L, RWKV_HEADS, HEAD_DIM).astype(jnp.float32)
    vh = v.reshape(B, L, RWKV_HEADS, HEAD_DIM).astype(jnp.float32)
    bonus = jnp.sum(rh * kh * r_k, axis=-1, keepdims=True) * vh
    out = (y + bonus).reshape(B, L, RWKV_WIDTH).astype(p.dtype)
    return out * g


def axial_rope_tables(n_tokens):
    rows = n_tokens // GRID_W
    inv_freq = ROPE_THETA ** (-jnp.arange(AXIS_FREQS, dtype=jnp.float32) * 2.0 / AXIS_DIM)
    row_ang = jnp.arange(rows, dtype=jnp.float32)[:, None] * inv_freq
    col_ang = jnp.arange(GRID_W, dtype=jnp.float32)[:, None] * inv_freq
    grid = jnp.stack([jnp.broadcast_to(row_ang[:, None, :], (rows, GRID_W, AXIS_FREQS)),
                      jnp.broadcast_to(col_ang[None, :, :], (rows, GRID_W, AXIS_FREQS))], axis=2)
    grid = grid.reshape(rows * GRID_W, 2, AXIS_FREQS)
    ang = jnp.concatenate([jnp.zeros((N_META, 2, AXIS_FREQS), jnp.float32), grid], axis=0)
    return jnp.cos(ang), jnp.sin(ang)


def apply_axial_rope(x, cos, sin):
    B, L, H, _ = x.shape
    xf = x.astype(jnp.float32).reshape(B, L, H, 2, 2, AXIS_FREQS)
    x1, x2 = xf[..., 0, :], xf[..., 1, :]
    c, s = cos[None, :, None], sin[None, :, None]
    out = jnp.stack([x1 * c - x2 * s, x2 * c + x1 * s], axis=-2)
    return out.reshape(B, L, H, HEAD_DIM).astype(x.dtype)


def gqa_axial_attention(q, k, v, q_norm_g, k_norm_g, cos, sin):
    B, L, _ = q.shape
    q = rms_norm(q.reshape(B, L, ATTN_Q_HEADS, HEAD_DIM), q_norm_g)
    k = rms_norm(k.reshape(B, L, ATTN_KV_HEADS, HEAD_DIM), k_norm_g)
    q = apply_axial_rope(q, cos, sin)
    k = apply_axial_rope(k, cos, sin)
    v = v.reshape(B, L, ATTN_KV_HEADS, HEAD_DIM)
    q = q.reshape(B, L, ATTN_KV_HEADS, ATTN_GROUP, HEAD_DIM) * (HEAD_DIM ** -0.5)

    def block_attn(qb):
        s = jnp.einsum('bqhgn,bkhn->bhgqk', qb, k).astype(jnp.float32)
        pr = jax.nn.softmax(s, axis=-1).astype(v.dtype)
        return jnp.einsum('bhgqk,bkhn->bqhgn', pr, v)

    meta_out = block_attn(q[:, :N_META])
    n_blk = (L - N_META) // Q_BLOCK
    qr = q[:, N_META:].reshape(B, n_blk, Q_BLOCK, ATTN_KV_HEADS, ATTN_GROUP, HEAD_DIM)
    real_out = lax.map(block_attn, qr.transpose(1, 0, 2, 3, 4, 5))
    real_out = real_out.transpose(1, 0, 2, 3, 4, 5).reshape(B, L - N_META, ATTN_Q_WIDTH)
    return jnp.concatenate([meta_out.reshape(B, N_META, ATTN_Q_WIDTH), real_out], axis=1)


def setup_inputs(seed: int = 0) -> dict:
    key = jax.random.key(seed)
    ks = jax.random.split(key, 26)
    f32 = jnp.float32

    def nrm(k, shape, scale):
        return jax.random.normal(k, shape, f32) * scale

    ramp = jnp.linspace(-6.5, -1.5, RWKV_WIDTH, dtype=f32)
    return {
        "x": nrm(ks[0], (BATCH, SEQ, D_MODEL), 1.0),
        "meta_tokens": nrm(ks[1], (N_META, D_MODEL), 1.0),
        "mix_norm_g": 1.0 + nrm(ks[2], (DEPTH, D_MODEL), 0.02),
        "w_in": nrm(ks[3], (DEPTH, D_MODEL, IN_WIDTH), D_MODEL ** -0.5),
        "rwkv_shift": jax.random.uniform(ks[4], (DEPTH, 2, RWKV_IN_WIDTH), f32, 0.0, 0.5),
        "decay_w0": ramp + nrm(ks[5], (DEPTH, N_DIR, RWKV_WIDTH), 0.1),
        "decay_w2": nrm(ks[6], (DEPTH, N_DIR, DECAY_LORA, RWKV_WIDTH), 0.5 * DECAY_LORA ** -0.5),
        "icl_a0": nrm(ks[7], (DEPTH, N_DIR, RWKV_WIDTH), 0.1),
        "icl_a2": nrm(ks[8], (DEPTH, N_DIR, ICL_LORA, RWKV_WIDTH), 0.5 * ICL_LORA ** -0.5),
        "gate_w2": nrm(ks[9], (DEPTH, GATE_LORA, RWKV_WIDTH), GATE_LORA ** -0.5),
        "k_k": 0.85 + nrm(ks[10], (DEPTH, RWKV_WIDTH), 0.02),
        "k_a": 1.0 + nrm(ks[11], (DEPTH, RWKV_WIDTH), 0.02),
        "r_k": nrm(ks[12], (DEPTH, RWKV_HEADS, HEAD_DIM), 0.1),
        "lnx_g": 1.0 + nrm(ks[13], (DEPTH, RWKV_WIDTH), 0.02),
        "lnx_b": nrm(ks[14], (DEPTH, RWKV_WIDTH), 0.02),
        "q_norm_g": 1.0 + nrm(ks[15], (DEPTH, HEAD_DIM), 0.02),
        "k_norm_g": 1.0 + nrm(ks[16], (DEPTH, HEAD_DIM), 0.02),
        "w_branch_rwkv": nrm(ks[17], (DEPTH, RWKV_WIDTH, D_MODEL), RWKV_WIDTH ** -0.5),
        "w_branch_attn": nrm(ks[18], (DEPTH, ATTN_Q_WIDTH, D_MODEL), ATTN_Q_WIDTH ** -0.5),
        "w_out": nrm(ks[19], (DEPTH, D_MODEL, D_MODEL), D_MODEL ** -0.5),
        "ffn_norm_g": 1.0 + nrm(ks[20], (DEPTH, D_MODEL), 0.02),
        "w_ff1": nrm(ks[21], (DEPTH, D_MODEL, D_FF), D_MODEL ** -0.5),
        "w_ff2": nrm(ks[22], (DEPTH, D_FF, D_MODEL), D_FF ** -0.5),
        "final_norm_g": 1.0 + nrm(ks[23], (D_MODEL,), 0.02),
    }


def reference(x, meta_tokens, mix_norm_g, w_in, rwkv_shift, decay_w0, decay_w2, icl_a0, icl_a2,
              gate_w2, k_k, k_a, r_k, lnx_g, lnx_b, q_norm_g, k_norm_g, w_branch_rwkv,
              w_branch_attn, w_out, ffn_norm_g, w_ff1, w_ff2, final_norm_g):
    B, n_tok, D = x.shape
    meta = jnp.broadcast_to(meta_tokens[None].astype(x.dtype), (B, N_META, D))
    h = jnp.concatenate([meta, x], axis=1)
    cos, sin = axial_rope_tables(n_tok)
    for i in range(DEPTH):
        u = rms_norm(h, mix_norm_g[i])
        proj = u @ w_in[i]
        p_rwkv, p_q, p_k, p_v, p_gate_a, p_gate_b = jnp.split(proj, IN_SPLITS, axis=-1)
        y_a = rwkv7_mixer(p_rwkv, rwkv_shift[i], decay_w0[i], decay_w2[i], icl_a0[i], icl_a2[i],
                          gate_w2[i], k_k[i], k_a[i], r_k[i], lnx_g[i], lnx_b[i])
        y_b = gqa_axial_attention(p_q, p_k, p_v, q_norm_g[i], k_norm_g[i], cos, sin)
        merged = (jax.nn.sigmoid(p_gate_a) * (y_a @ w_branch_rwkv[i])
                  + jax.nn.sigmoid(p_gate_b) * (y_b @ w_branch_attn[i]))
        h = h + merged @ w_out[i]
        f = rms_norm(h, ffn_norm_g[i]) @ w_ff1[i]
        h = h + jnp.square(jax.nn.relu(f)) @ w_ff2[i]
    return rms_norm(h, final_norm_g)[:, N_META:]
```

```cpp
#include <hip/hip_runtime.h>
#include <hip/hip_cooperative_groups.h>
#include <hip/hip_bf16.h>
#include <cstdio>
#include <cstdint>
#include <cmath>
namespace cg = cooperative_groups;
__device__ __forceinline__ int otid() { int t; asm volatile("v_mov_b32 %0, %1" : "=v"(t) : "v"((int)threadIdx.x)); return t; }
namespace pg8 {
#define PG8_LAS __attribute__((address_space(3)))
typedef unsigned short bf16_t;
typedef short bf16x8 __attribute__((ext_vector_type(8)));
typedef float f32x4 __attribute__((ext_vector_type(4)));
typedef unsigned u32x4 __attribute__((ext_vector_type(4)));
constexpr int BM = 256, BK = 64, HALF = 128, HTB = HALF * BK * 2  , STAGE_BYTES = 8 * HTB, NXCD = 8, WGM = 8;

__host__ __device__ __forceinline__ int lds_byte(int r, int c) { const int st = (r >> 4) * 2 + (c >> 5), rr = r & 15, cc = c & 31, ob = rr * 64 + cc * 2; return st * 1024 + (ob ^ (((ob >> 9) & 1) << 5)); }
__host__ __device__ __forceinline__ void stage_rc(int b, int& R, int& C) { const int st = b / 1024, sb = b % 1024, swz = sb ^ (((sb >> 9) & 1) << 5); R = (st >> 1) * 16 + swz / 64; C = (st & 1) * 32 + (swz % 64) / 2; }
__host__ __device__ __forceinline__ int perm32(int rho) { const int n = rho >> 4, i = rho & 15; return 8 * (i >> 2) + 4 * n + (i & 3); }

struct Unit { int pm, pn; };
struct Gemm { const bf16_t* A; const bf16_t* Bt; int M, N, K, lda, ldb; };

struct StaticOrder {
    int nM, nN, nwg, G, c;
    __host__ __device__ void init(int M, int N, int G_, int c_) { nM = M / BM; nN = N / BM; nwg = nM * nN; G = G_; c = c_; }
    __host__ __device__ bool next(int i, Unit& u) const {
        const long L = (long)i * G + c; if (L >= nwg) return false;
        int wgid = (int)L; { const int q = nwg / NXCD, r = nwg % NXCD, xcd = wgid % NXCD, off = wgid / NXCD; wgid = (xcd < r ? xcd * (q + 1) : r * (q + 1) + (xcd - r) * q) + off; }
        const int nig = WGM * nN, gid = wgid / nig, fm = gid * WGM, gsz = (nM - fm) < WGM ? (nM - fm) : WGM;
        u.pm = fm + ((wgid % nig) % gsz); u.pn = (wgid % nig) / gsz; return true;
    }
    __device__ __forceinline__ void a_ready(const Unit&) const {}
    __device__ __forceinline__ void done(const Unit&) const {}
};
typedef unsigned u32x2 __attribute__((ext_vector_type(2)));
typedef float f32x2c_t __attribute__((ext_vector_type(2))); typedef __bf16 bf16x2c_t __attribute__((ext_vector_type(2)));
__device__ __forceinline__ unsigned cvt_pk_bf16(float lo, float hi) { f32x2c_t v = {lo, hi}; bf16x2c_t b = __builtin_convertvector(v, bf16x2c_t); return __builtin_bit_cast(unsigned, b); }
__device__ __forceinline__ float bf_lo(unsigned w) { return __uint_as_float(w << 16); }
__device__ __forceinline__ float bf_hi(unsigned w) { return __uint_as_float(w & 0xffff0000u); }
__device__ __forceinline__ float sigmoidf_(float x) { return __builtin_amdgcn_rcpf(1.0f + __expf(-x)); }
#define EPI_LOOP_PERM(BODY) \
    _Pragma("unroll") for (int ai = 0; ai < 2; ++ai) _Pragma("unroll") for (int m = 0; m < 4; ++m) { const int row = row0 + ai * HALF + m * 16; \
        _Pragma("unroll") for (int bj = 0; bj < 2; ++bj) { const int col = col0 + bj * HALF; f32x4 v0 = acc[ai][bj][m][0], v1 = acc[ai][bj][m][1]; BODY } }
struct EpiSplit {
    static constexpr bool PERM = true, AFTER_DRAIN = false;
    bf16_t *p_rwkv, *p_q, *p_kv;
    __device__ __forceinline__ void operator()(const f32x4 (&acc)[2][2][4][2], const Unit& u, int wr, int wc, int fr, int fq) const {
        bf16_t* base; int ldc, colt;
        if (u.pn < 8) { base = p_rwkv; ldc = 2048; colt = u.pn * 256; } else if (u.pn < 10) { base = p_q; ldc = 512; colt = (u.pn - 8) * 256; } else { base = p_kv; ldc = 256; colt = 0; }
        const int row0 = u.pm * BM + wr * 64 + fr, col0 = colt + wc * 32 + 8 * fq;
        EPI_LOOP_PERM( u32x4 w; w.x = cvt_pk_bf16(v0[0], v0[1]); w.y = cvt_pk_bf16(v0[2], v0[3]); w.z = cvt_pk_bf16(v1[0], v1[1]); w.w = cvt_pk_bf16(v1[2], v1[3]);
                       *(u32x4*)(base + (size_t)row * ldc + col) = w; )
    }
};
template <int ACT, bool BIAS> struct EpiAct {
    static constexpr bool PERM = true, AFTER_DRAIN = false;
    bf16_t* O; int ldc; const float* bias; float scale;
    __device__ __forceinline__ void operator()(const f32x4 (&acc)[2][2][4][2], const Unit& u, int wr, int wc, int fr, int fq) const {
        const int row0 = u.pm * BM + wr * 64 + fr, col0 = u.pn * BM + wc * 32 + 8 * fq;
        _Pragma("unroll") for (int bj = 0; bj < 2; ++bj) { const int col = col0 + bj * HALF;
            _Pragma("unroll") for (int ai = 0; ai < 2; ++ai) _Pragma("unroll") for (int m = 0; m < 4; ++m) { const int row = row0 + ai * HALF + m * 16;
                f32x4 b0 = {0.f, 0.f, 0.f, 0.f}, b1 = b0; if (BIAS) { b0 = *(const f32x4*)(bias + col); b1 = *(const f32x4*)(bias + col + 4); }
                f32x4 v0 = acc[ai][bj][m][0] + b0, v1 = acc[ai][bj][m][1] + b1;
                if (ACT == 1) { _Pragma("unroll") for (int e = 0; e < 4; ++e) { v0[e] = sigmoidf_(v0[e]); v1[e] = sigmoidf_(v1[e]); } }
                v0 = v0 * scale; v1 = v1 * scale;
                u32x4 w; w.x = cvt_pk_bf16(v0[0], v0[1]); w.y = cvt_pk_bf16(v0[2], v0[3]); w.z = cvt_pk_bf16(v1[0], v1[1]); w.w = cvt_pk_bf16(v1[2], v1[3]);
                *(u32x4*)(O + (size_t)row * ldc + col) = w; asm volatile("" ::: "memory"); } }
    }
};
struct EpiMul {
    static constexpr bool PERM = true, AFTER_DRAIN = false;
    bf16_t* O; const bf16_t* mul; int mcol; const bf16_t* add;
    __device__ __forceinline__ void operator()(const f32x4 (&acc)[2][2][4][2], const Unit& u, int wr, int wc, int fr, int fq) const {
        const int row0 = u.pm * BM + wr * 64 + fr, col0 = u.pn * BM + wc * 32 + 8 * fq;
        EPI_LOOP_PERM( const u32x4 g = *(const u32x4*)(mul + (size_t)row * 2048 + mcol + col);
                       v0[0] *= bf_lo(g.x); v0[1] *= bf_hi(g.x); v0[2] *= bf_lo(g.y); v0[3] *= bf_hi(g.y); v1[0] *= bf_lo(g.z); v1[1] *= bf_hi(g.z); v1[2] *= bf_lo(g.w); v1[3] *= bf_hi(g.w);
                       if (add) { const u32x4 a = *(const u32x4*)(add + (size_t)row * 1024 + col);
                           v0[0] += bf_lo(a.x); v0[1] += bf_hi(a.x); v0[2] += bf_lo(a.y); v0[3] += bf_hi(a.y); v1[0] += bf_lo(a.z); v1[1] += bf_hi(a.z); v1[2] += bf_lo(a.w); v1[3] += bf_hi(a.w); }
                       u32x4 w; w.x = cvt_pk_bf16(v0[0], v0[1]); w.y = cvt_pk_bf16(v0[2], v0[3]); w.z = cvt_pk_bf16(v1[0], v1[1]); w.w = cvt_pk_bf16(v1[2], v1[3]);
                       *(u32x4*)(O + (size_t)row * 1024 + col) = w; )
    }
};
struct EpiFF1 {
    static constexpr bool PERM = true, AFTER_DRAIN = false;
    bf16_t* O; const float* rowss;
    __device__ __forceinline__ void operator()(const f32x4 (&acc)[2][2][4][2], const Unit& u, int wr, int wc, int fr, int fq) const {
        const int row0 = u.pm * BM + wr * 64 + fr, col0 = u.pn * BM + wc * 32 + 8 * fq;
        _Pragma("unroll") for (int ai = 0; ai < 2; ++ai) _Pragma("unroll") for (int m = 0; m < 4; ++m) { const int row = row0 + ai * HALF + m * 16;
            const float rs = rsqrtf(__hip_atomic_load(rowss + row, __ATOMIC_RELAXED, __HIP_MEMORY_SCOPE_AGENT) * (1.0f / 1024.0f) + 1e-6f);
            _Pragma("unroll") for (int bj = 0; bj < 2; ++bj) { const int col = col0 + bj * HALF; f32x4 v0 = acc[ai][bj][m][0] * rs, v1 = acc[ai][bj][m][1] * rs;
                _Pragma("unroll") for (int e = 0; e < 4; ++e) { const float a = fmaxf(v0[e], 0.f), b = fmaxf(v1[e], 0.f); v0[e] = a * a; v1[e] = b * b; }
                u32x4 w; w.x = cvt_pk_bf16(v0[0], v0[1]); w.y = cvt_pk_bf16(v0[2], v0[3]); w.z = cvt_pk_bf16(v1[0], v1[1]); w.w = cvt_pk_bf16(v1[2], v1[3]);
                *(u32x4*)(O + (size_t)row * 4096 + col) = w; } }
    }
};
struct EpiRes {
    static constexpr bool PERM = false, AFTER_DRAIN = false;
    const float* base; float* out; bf16_t* hn; float* rowss;
    __device__ __forceinline__ void operator()(const f32x4 (&acc)[2][2][4][2], const Unit& u, int wr, int wc, int fr, int fq) const {
        const int row0 = u.pm * BM + wr * 64 + fr, col0 = u.pn * BM + wc * 32 + 4 * fq;
        _Pragma("unroll") for (int ai = 0; ai < 2; ++ai) _Pragma("unroll") for (int m = 0; m < 4; ++m) { const int row = row0 + ai * HALF + m * 16; float ss = 0.f;
            _Pragma("unroll") for (int bj = 0; bj < 2; ++bj) _Pragma("unroll") for (int n = 0; n < 2; ++n) { const size_t off = (size_t)row * 1024 + col0 + bj * HALF + n * 16;
                const f32x4 o = *(const f32x4*)(base + off) + acc[ai][bj][m][n]; *(f32x4*)(out + off) = o; ss += (o[0] * o[0] + o[1] * o[1]) + (o[2] * o[2] + o[3] * o[3]);
                if (hn) { u32x2 w; w.x = cvt_pk_bf16(o[0], o[1]); w.y = cvt_pk_bf16(o[2], o[3]); *(u32x2*)(hn + off) = w; } }
            ss += __shfl_xor(ss, 16); ss += __shfl_xor(ss, 32);
            if (fq == 0) atomicAdd(rowss + row, ss); }
    }
};
template <class Epi, class Sched, bool ALIGN_EPI = false>
__device__ __forceinline__ void gemm_phase(PG8_LAS unsigned char* lds, const Gemm g, const Sched& S, const Epi& E) {
    const int tid = otid(), wid = __builtin_amdgcn_readfirstlane(tid >> 6), lane = tid & 63, wr = wid >> 2, wc = wid & 3, fr = lane & 15, fq = lane >> 4;
    const int K = g.K, nt = K / BK;
    unsigned voffA[2], voffB[2];
#pragma unroll
    for (int i = 0; i < 2; ++i) { int R, C; stage_rc(tid * 16 + i * 8192, R, C); const int Rb = Epi::PERM ? ((R & ~31) + perm32(R & 31)) : R;
        voffA[i] = (unsigned)(R * g.lda + C) * 2u; voffB[i] = (unsigned)(Rb * g.ldb + C) * 2u; }
    const size_t kstep = (size_t)(BK * 2);
    const size_t hstepA = (size_t)HALF * g.lda * 2, hstepB = (size_t)HALF * g.ldb * 2;
    const size_t tstepA = 2 * hstepA, tstepB = 2 * hstepB;
    const unsigned ldsw = (unsigned)wid * 1024u;
    const int aoff = lds_byte(wr * 64 + fr, fq * 8), boff = lds_byte(wc * 32 + fr, fq * 8);
#define PG8_SA(b, h) (((b) * 2 + (h)) * HTB)
#define PG8_SB(b, h) ((4 + (b) * 2 + (h)) * HTB)
#define PG8_STAGE(bufoff, gbase, voff) do { _Pragma("unroll") for (int _i = 0; _i < 2; ++_i) \
        __builtin_amdgcn_global_load_lds((const unsigned*)((const char*)(gbase) + (voff)[_i]), (PG8_LAS unsigned*)(lds + (bufoff) + ldsw + _i * 8192), 16, 0, 0); } while (0)
#define PG8_LDA(dst, b, h) do { _Pragma("unroll") for (int m = 0; m < 4; ++m) _Pragma("unroll") for (int k = 0; k < 2; ++k) dst[m][k] = *(const PG8_LAS bf16x8*)(lds + PG8_SA(b, h) + aoff + m * 2048 + k * 1024); } while (0)
#define PG8_LDB(dst, b, h) do { _Pragma("unroll") for (int n = 0; n < 2; ++n) _Pragma("unroll") for (int k = 0; k < 2; ++k) dst[n][k] = *(const PG8_LAS bf16x8*)(lds + PG8_SB(b, h) + boff + n * 2048 + k * 1024); } while (0)
#define PG8_MMA(ai, bj, At, Bt) do { __builtin_amdgcn_s_setprio(1); _Pragma("unroll") for (int m = 0; m < 4; ++m) _Pragma("unroll") for (int n = 0; n < 2; ++n) _Pragma("unroll") for (int k = 0; k < 2; ++k) \
        acc[ai][bj][m][n] = __builtin_amdgcn_mfma_f32_16x16x32_bf16(Bt[n][k], At[m][k], acc[ai][bj][m][n], 0, 0, 0); __builtin_amdgcn_s_setprio(0); } while (0)
#define PG8_WAIT_V(n) asm volatile("s_waitcnt vmcnt(" #n ")" ::: "memory")
#define PG8_WAIT_L(n) asm volatile("s_waitcnt lgkmcnt(" #n ")" ::: "memory")
#define PG8_BAR asm volatile("s_barrier" ::: "memory")
#define PG8_SCHED __builtin_amdgcn_sched_barrier(0)
    Unit cur, nxt; int ui = 0;
    if (!S.next(0, cur)) return;
    f32x4 acc[2][2][4][2];
#pragma unroll
    for (int a = 0; a < 2; ++a)
#pragma unroll
        for (int b = 0; b < 2; ++b)
#pragma unroll
            for (int m = 0; m < 4; ++m)
#pragma unroll
                for (int n = 0; n < 2; ++n) acc[a][b][m][n] = (f32x4){0.f, 0.f, 0.f, 0.f};
    bf16x8 At[4][2], B0[2][2], B1[2][2];
    const char* cA = (const char*)g.A + (size_t)cur.pm * tstepA; const char* cB = (const char*)g.Bt + (size_t)cur.pn * tstepB;
    S.a_ready(cur);
    {
        PG8_STAGE(PG8_SB(0, 0), cB, voffB); PG8_STAGE(PG8_SB(0, 1), cB + hstepB, voffB); PG8_STAGE(PG8_SA(0, 0), cA, voffA); PG8_STAGE(PG8_SA(0, 1), cA + hstepA, voffA);
        if (wr == 1) PG8_BAR;
        PG8_WAIT_V(2); PG8_BAR;
        PG8_STAGE(PG8_SB(1, 0), cB + kstep, voffB); PG8_STAGE(PG8_SA(1, 0), cA + kstep, voffA); PG8_STAGE(PG8_SB(1, 1), cB + hstepB + kstep, voffB);
        PG8_WAIT_V(6); PG8_BAR;
    }
    for (;;) {
        const bool has_next = S.next(ui + 1, nxt);
        const char* nA = has_next ? (const char*)g.A + (size_t)nxt.pm * tstepA : cA; const char* nB = has_next ? (const char*)g.Bt + (size_t)nxt.pn * tstepB : cB;
        for (int t = 0; t < nt; t += 2) {
            const bool last = (t == nt - 2);
            const char* a1 = cA + (size_t)(t + 1) * kstep;
            const char* a2 = last ? nA : cA + (size_t)(t + 2) * kstep; const char* b2 = last ? nB : cB + (size_t)(t + 2) * kstep;
            const char* a3 = a2 + kstep; const char* b3 = b2 + kstep;
            if (last && has_next) S.a_ready(nxt);
            {
            PG8_LDB(B0, 0, 0); PG8_LDB(B1, 0, 1); PG8_SCHED; PG8_LDA(At, 0, 0); PG8_STAGE(PG8_SA(1, 1), a1 + hstepA, voffA);
            PG8_WAIT_V(8); PG8_WAIT_L(0); PG8_BAR; PG8_MMA(0, 0, At, B0); PG8_MMA(0, 1, At, B1); PG8_BAR; PG8_SCHED;
            PG8_LDA(At, 0, 1); PG8_STAGE(PG8_SB(0, 0), b2, voffB); PG8_STAGE(PG8_SB(0, 1), b2 + hstepB, voffB); PG8_STAGE(PG8_SA(0, 0), a2, voffA);
            PG8_WAIT_V(8); PG8_WAIT_L(0); PG8_BAR; PG8_MMA(1, 0, At, B0); PG8_MMA(1, 1, At, B1); PG8_BAR; PG8_SCHED;
            PG8_LDB(B0, 1, 0); PG8_LDB(B1, 1, 1); PG8_SCHED; PG8_LDA(At, 1, 0); PG8_STAGE(PG8_SA(0, 1), a2 + hstepA, voffA);
            PG8_WAIT_V(8); PG8_WAIT_L(0); PG8_BAR; PG8_MMA(0, 0, At, B0); PG8_MMA(0, 1, At, B1); PG8_BAR; PG8_SCHED;
            PG8_LDA(At, 1, 1); PG8_STAGE(PG8_SB(1, 0), b3, voffB); PG8_STAGE(PG8_SB(1, 1), b3 + hstepB, voffB); PG8_STAGE(PG8_SA(1, 0), a3, voffA);
            PG8_WAIT_V(8); PG8_WAIT_L(0); PG8_BAR; PG8_MMA(1, 0, At, B0); PG8_MMA(1, 1, At, B1); PG8_BAR; PG8_SCHED;
            }
        }
        if constexpr (ALIGN_EPI) { if (wr == 0) PG8_BAR; }
        if constexpr (!Epi::AFTER_DRAIN) { E(acc, cur, wr, wc, fr, fq); S.done(cur); }
        if (!has_next) break;
#pragma unroll
        for (int a = 0; a < 2; ++a)
#pragma unroll
            for (int b = 0; b < 2; ++b)
#pragma unroll
                for (int m = 0; m < 4; ++m)
#pragma unroll
                    for (int n = 0; n < 2; ++n) acc[a][b][m][n] = (f32x4){0.f, 0.f, 0.f, 0.f};
        cur = nxt; cA = nA; cB = nB; ++ui;
        if constexpr (ALIGN_EPI) { if (wr == 1) PG8_BAR; }
    }
    PG8_WAIT_V(0);
    if constexpr (!ALIGN_EPI) { if (wr == 0) PG8_BAR; }
    PG8_BAR;
    if constexpr (Epi::AFTER_DRAIN) { E.fused(acc, cur, wr, wc, fr, fq, lds, wid, lane); S.done(cur); }
#undef PG8_SA
#undef PG8_SB
#undef PG8_STAGE
#undef PG8_LDA
#undef PG8_LDB
#undef PG8_MMA
#undef PG8_WAIT_V
#undef PG8_WAIT_L
#undef PG8_BAR
#undef PG8_SCHED
}
}
#include <hip/hip_bf16.h>
#include <cmath>
namespace attn_body {
using bf16=__hip_bfloat16;
using bf16x8=__attribute__((ext_vector_type(8)))short;
using s16x4=__attribute__((ext_vector_type(4)))short;
using f32x16=__attribute__((ext_vector_type(16)))float;
using u32x4=__attribute__((ext_vector_type(4)))unsigned;
constexpr int BATCH=4,NHEAD=8,SEQ=4096,KSEQ=4224,KVALID=4112,D=64,DM=512,DMKV=128;
constexpr int NW=8,QBLK=32,QB=QBLK*NW,KVBLK=64,NQB=SEQ/QB;
constexpr int ATTN_PITCH=DM, ATTN_UNIT_ROWS=QB;
__device__ __forceinline__ void kmask(f32x16&p0,f32x16&p1,int t,int hi){
  const float NEG=-INFINITY; const int kb=64*t+4*hi;
  #pragma unroll
  for(int r=0;r<16;++r){int kv=kb+(r&3)+8*(r>>2); if(kv>=KVALID)p0[r]=NEG; if(kv+32>=KVALID)p1[r]=NEG;}
}
__device__ __forceinline__ int crow(int r,int hi){return (r&3)+8*(r>>2)+4*hi;}
#define SBAR() __builtin_amdgcn_sched_barrier(0)
__device__ __forceinline__ void cmask(f32x16&p0,f32x16&p1,int jb,int qrel,int hi){
  const float NEG=-INFINITY; int kb=64*jb+4*hi;
  #pragma unroll
  for(int r=0;r<16;++r){int kv=kb+(r&3)+8*(r>>2); if(kv>qrel)p0[r]=NEG; if(kv+32>qrel)p1[r]=NEG;}
}

constexpr int NSLOT=3, SLOTB=8192;
constexpr int LDS_K=0, LDS_V=NSLOT*SLOTB, LDS_WS=2*NSLOT*SLOTB, LDS_OST=LDS_WS+NW*64*4, LDS_BYTES=LDS_OST+NW*4096;
constexpr float C2=0.125f*1.4426950408889634f;
__device__ __forceinline__ void glds16(const void*gsrc,unsigned lds_dst){unsigned keep;
  asm volatile("s_mov_b32 %0, m0\n\ts_mov_b32 m0, %2\n\ts_nop 0\n\tglobal_load_lds_dwordx4 %1, off\n\ts_mov_b32 m0, %0":"=&s"(keep):"v"(gsrc),"s"(lds_dst):"memory");}
__device__ __forceinline__ float max3f(float a,float b,float c){float r;asm("v_max3_f32 %0, %1, %2, %3":"=v"(r):"v"(a),"v"(b),"v"(c));return r;}
__device__ __forceinline__ float max2f(float a,float b){float r;asm("v_max_f32_e32 %0, %1, %2":"=v"(r):"v"(a),"v"(b));return r;}
__device__ __forceinline__ float fadd_s(float a,float b){float r;asm("v_add_f32_e32 %0, %1, %2":"=v"(r):"v"(a),"v"(b));return r;}
__device__ __forceinline__ float fsub_s(float a,float b){float r;asm("v_sub_f32_e32 %0, %1, %2":"=v"(r):"v"(a),"v"(b));return r;}
typedef float f32x2_t __attribute__((ext_vector_type(2))); typedef __bf16 bf16x2_t __attribute__((ext_vector_type(2)));
__device__ __forceinline__ unsigned cvtpk_s(float lo,float hi){f32x2_t v={lo,hi};bf16x2_t b=__builtin_convertvector(v,bf16x2_t);return __builtin_bit_cast(unsigned,b);}
#define WAIT_BAR(N) asm volatile("s_waitcnt vmcnt(" #N ") lgkmcnt(0)\n\ts_barrier":::"memory")

__device__ __forceinline__ void qkt(f32x16&p0,f32x16&p1,const char*Kslot,const bf16x8*qr,const f32x16&negm,int r32,int hi){
  const char*kb=Kslot+hi*1024+r32*16;
  #pragma unroll
  for(int d0=0;d0<4;++d0){
    const bf16x8 b0=*reinterpret_cast<const bf16x8*>(kb+d0*2048);
    const bf16x8 b1=*reinterpret_cast<const bf16x8*>(kb+d0*2048+512);
    if(d0==0){p0=__builtin_amdgcn_mfma_f32_32x32x16_bf16(b0,qr[0],negm,0,0,0);p1=__builtin_amdgcn_mfma_f32_32x32x16_bf16(b1,qr[0],negm,0,0,0);}
    else{p0=__builtin_amdgcn_mfma_f32_32x32x16_bf16(b0,qr[d0],p0,0,0,0);p1=__builtin_amdgcn_mfma_f32_32x32x16_bf16(b1,qr[d0],p1,0,0,0);}}
}
typedef __attribute__((address_space(3))) const char* lds_cptr;
typedef short v4i16_t __attribute__((ext_vector_type(4)));
__device__ __forceinline__ void kload8(bf16x8*kf,lds_cptr kp){
  kf[0]=*(const __attribute__((address_space(3))) bf16x8*)(kp);      kf[1]=*(const __attribute__((address_space(3))) bf16x8*)(kp+512);
  kf[2]=*(const __attribute__((address_space(3))) bf16x8*)(kp+2048); kf[3]=*(const __attribute__((address_space(3))) bf16x8*)(kp+2560);
  kf[4]=*(const __attribute__((address_space(3))) bf16x8*)(kp+4096); kf[5]=*(const __attribute__((address_space(3))) bf16x8*)(kp+4608);
  kf[6]=*(const __attribute__((address_space(3))) bf16x8*)(kp+6144); kf[7]=*(const __attribute__((address_space(3))) bf16x8*)(kp+6656);
}
__device__ __forceinline__ void kload2(bf16x8*kf,lds_cptr kp,int j){ kf[2*j]=*(const __attribute__((address_space(3))) bf16x8*)(kp+j*2048); kf[2*j+1]=*(const __attribute__((address_space(3))) bf16x8*)(kp+j*2048+512); }
__device__ __forceinline__ s16x4 vtr(lds_cptr p){ return __builtin_bit_cast(s16x4,__builtin_amdgcn_ds_read_tr16_b64_v4i16((__attribute__((address_space(3))) v4i16_t*)p)); }
__device__ __forceinline__ float rowmax(const f32x16&p0,const f32x16&p1){
  float a=max3f(p0[0],p0[1],p1[0]),b=max3f(p0[2],p0[3],p1[1]);a=max3f(a,p1[2],p1[3]);
  #pragma unroll
  for(int r=4;r<16;r+=4){a=max3f(a,p0[r],p0[r+1]);b=max3f(b,p0[r+2],p0[r+3]);a=max3f(a,p1[r],p1[r+1]);b=max3f(b,p1[r+2],p1[r+3]);}
  const float m=max2f(a,b);
  auto rr=__builtin_amdgcn_permlane32_swap(__float_as_uint(m),__float_as_uint(m),false,false);
  return max2f(__uint_as_float(rr[0]),__uint_as_float(rr[1]));
}
__device__ __forceinline__ void pv(f32x16*o,int vb,bf16x8 pa0,bf16x8 pa1,bf16x8 pa2,bf16x8 pa3){
  #pragma unroll
  for(int d0=0;d0<2;++d0){s16x4 lo[4],hi[4];
    #pragma unroll
    for(int ks=0;ks<4;++ks){
      asm volatile("ds_read_b64_tr_b16 %0,%1 offset:%c2":"=&v"(lo[ks]):"v"(vb),"i"(d0*4096+ks*1024):"memory");
      asm volatile("ds_read_b64_tr_b16 %0,%1 offset:%c2":"=&v"(hi[ks]):"v"(vb),"i"(d0*4096+ks*1024+512):"memory");}
    asm volatile("s_waitcnt lgkmcnt(0)":::"memory");SBAR();
    #define PK(k) (bf16x8){lo[k][0],lo[k][1],lo[k][2],lo[k][3],hi[k][0],hi[k][1],hi[k][2],hi[k][3]}
    o[d0]=__builtin_amdgcn_mfma_f32_32x32x16_bf16(pa0,PK(0),o[d0],0,0,0);
    o[d0]=__builtin_amdgcn_mfma_f32_32x32x16_bf16(pa1,PK(1),o[d0],0,0,0);
    o[d0]=__builtin_amdgcn_mfma_f32_32x32x16_bf16(pa2,PK(2),o[d0],0,0,0);
    o[d0]=__builtin_amdgcn_mfma_f32_32x32x16_bf16(pa3,PK(3),o[d0],0,0,0);
    #undef PK
  }
}

#ifndef ATTN_STORE16
#define ATTN_STORE16(p,v) (*(u32x4*)(p)=(v))
#endif
template<int THRL> __device__ __forceinline__ void attn_unit(int b,int h,int qb,const bf16*Q,const bf16*__restrict__ K,const bf16*__restrict__ V,bf16*O,char*shm){
  const int tid=otid(),lane=tid&63,r32=lane&31,hi=lane>>5; const int wid=__builtin_amdgcn_readfirstlane(tid>>6);
  const long rowbase=(long)b*SEQ; const long kvbase=(long)b*KSEQ; const int q0=qb*QB;
  const bf16*Qw=Q+(rowbase+q0+wid*QBLK)*DM+h*D;
  const bf16*Kh=K+kvbase*DMKV+(h>>2)*D,*Vh=V+kvbase*DMKV+(h>>2)*D;
  const unsigned lds0=(unsigned)(uintptr_t)shm;
  float*wsf=(float*)(shm+LDS_WS)+wid*64;
  const bf16*ksrc=Kh+(long)lane*DMKV+wid*8;
  const bf16*vsrc=Vh+(long)(16*(wid&3)+(lane>>2))*DMKV+(wid>>2)*32+(lane&3)*8;
  const unsigned kdst=lds0+LDS_K+wid*1024, vdst=lds0+LDS_V+wid*1024;
  #define DMA_K(t,slot) glds16(ksrc+(long)(t)*KVBLK*DMKV,(unsigned)__builtin_amdgcn_readfirstlane(kdst+(slot)))
  #define DMA_V(t,slot) glds16(vsrc+(long)(t)*KVBLK*DMKV,(unsigned)__builtin_amdgcn_readfirstlane(vdst+(slot)))
  const int vb0=(int)(lds0+LDS_V)+((lane>>4)&1)*32+(lane&3)*8+(4*hi+((lane&15)>>2))*64;
  const char*Kbase=shm+LDS_K; bf16x8 kf[8];
  const lds_cptr shm3=(lds_cptr)shm; const lds_cptr kp0=shm3+LDS_K+hi*1024+r32*16; const lds_cptr vp0=shm3+LDS_V+((lane>>4)&1)*32+(lane&3)*8+(4*hi+((lane&15)>>2))*64;
  const int NT=KSEQ/KVBLK;
  DMA_K(0,0);DMA_V(0,0);DMA_K(1,SLOTB);
  bf16x8 qr[4];
  #pragma unroll
  for(int d0=0;d0<4;++d0)qr[d0]=*reinterpret_cast<const bf16x8*>(&Qw[(long)r32*DM+d0*16+hi*8]);
  float mhat=0.f,l_reg=0.f;f32x16 o[2];o[0]=f32x16{};o[1]=f32x16{};f32x16 negm=f32x16{};asm volatile("":"+v"(negm));
  const int qrel=wid*QBLK+r32;
  #define CMASK(P0,P1,t) do{int jb_=(t)-(NT-4); if(jb_>=0)kmask(P0,P1,(t),hi);}while(0)
  bool resc=false;
  #define START(P0,P1) do{ const float rm=rowmax(P0,P1); resc=false; \
    { const float dl=rm; mhat=fadd_s(mhat,dl); \
      _Pragma("unroll") for(int r=0;r<16;++r){P0[r]=fsub_s(P0[r],dl);P1[r]=fsub_s(P1[r],dl);} \
      _Pragma("unroll") for(int r=0;r<16;++r)negm[r]=-mhat; asm volatile("":"+v"(negm)); } \
    _Pragma("unroll") for(int r=0;r<16;++r)P0[r]=__builtin_amdgcn_exp2f(P0[r]); }while(0)
  #define RESC() do{ if(resc){ asm volatile("s_waitcnt lgkmcnt(0)":::"memory"); \
      _Pragma("unroll") for(int d_=0;d_<2;++d_) _Pragma("unroll") for(int r=0;r<16;++r)o[d_][r]*=wsf[crow(r,hi)]; } }while(0)
  f32x16 pA0,pA1,pB0,pB1;
  int sl_prev=0,sl_cur=0,sl_next=SLOTB;
  #define ROT() do{sl_prev=sl_cur;sl_cur=sl_next;sl_next=(sl_next==(NSLOT-1)*SLOTB)?0:sl_next+SLOTB;}while(0)
  DMA_K(2,2*SLOTB);
  WAIT_BAR(3);
  qkt(pA0,pA1,Kbase,qr,negm,r32,hi);asm volatile("s_nop 15\n\ts_nop 7":"+v"(pA0),"+v"(pA1));CMASK(pA0,pA1,0);
  START(pA0,pA1);
  _Pragma("unroll") for(int r=0;r<16;++r)pA1[r]=__builtin_amdgcn_exp2f(pA1[r]);
  WAIT_BAR(0);
  DMA_K(3,0);DMA_V(1,SLOTB);
  ROT();
  kload8(kf,kp0+sl_cur);
  WAIT_BAR(2);
  s16x4 vlo[8],vhi[8]; u32x4 pw0,pw1,pw2,pw3;
  #define PKW(P,B) cvtpk_s(P[B],P[B+1])
  #define PAF(k) __builtin_bit_cast(bf16x8,pw##k)
  #define VFR(i) (bf16x8){vlo[i][0],vlo[i][1],vlo[i][2],vlo[i][3],vhi[i][0],vhi[i][1],vhi[i][2],vhi[i][3]}
  #define PIN(x) asm volatile("":"+v"(x))
  #define MX3(a,b,c) __builtin_fmaxf(__builtin_fmaxf((a),(b)),(c))
  #define GAPA(MF,A0,A1,A2,A3,W0,W1,PW) do{ MF; sacc+=A0; sacc+=A1; sacc+=A2; sacc+=A3; PIN(sacc); W0; W1; PIN(PW); SBAR(); }while(0)
  #define EX(v) __builtin_amdgcn_exp2f(v)
  #define GAPB(MF,X,B) do{ MF; X[B]=EX(X[B]); X[B+1]=EX(X[B+1]); X[B+2]=EX(X[B+2]); X[B+3]=EX(X[B+3]); PIN(X); SBAR(); }while(0)
  #define VRD(i) do{ vlo[i]=vtr(vp_+(((i)>>2)*4096+((i)&3)*1024)); vhi[i]=vtr(vp_+(((i)>>2)*4096+((i)&3)*1024+512)); }while(0)
  #define KRD(G,j) do{ if(G){ kload2(kf,kp0+sl_next,j); SBAR(); } }while(0)
  #define STEP(C0,C1,P0,P1,t,GK,GV,GL) do{ SBAR(); \
    const lds_cptr vp_=vp0+sl_prev; \
    VRD(0); SBAR(); float sacc=(P0[0]+P0[1]); \
    GAPA(C0=__builtin_amdgcn_mfma_f32_32x32x16_bf16(kf[0],qr[0],negm,0,0,0), P0[2],P0[3],P0[4],P0[5],     pw0[0]=PKW(P0,0), pw0[1]=PKW(P0,2), pw0); \
    VRD(4); SBAR(); GAPA(C1=__builtin_amdgcn_mfma_f32_32x32x16_bf16(kf[1],qr[0],negm,0,0,0), P0[6],P0[7],P0[8],P0[9],     pw0[2]=PKW(P0,4), pw0[3]=PKW(P0,6), pw0); \
    VRD(1); SBAR(); GAPA(C0=__builtin_amdgcn_mfma_f32_32x32x16_bf16(kf[2],qr[1],C0,0,0,0),   P0[10],P0[11],P0[12],P0[13], pw1[0]=PKW(P0,8), pw1[1]=PKW(P0,10), pw1); \
    VRD(5); SBAR(); GAPA(C1=__builtin_amdgcn_mfma_f32_32x32x16_bf16(kf[3],qr[1],C1,0,0,0),   P0[14],P0[15],P1[0],P1[1],   pw1[2]=PKW(P0,12),pw1[3]=PKW(P0,14), pw1); \
    VRD(2); SBAR(); GAPA(C0=__builtin_amdgcn_mfma_f32_32x32x16_bf16(kf[4],qr[2],C0,0,0,0),   P1[2],P1[3],P1[4],P1[5],     pw2[0]=PKW(P1,0), pw2[1]=PKW(P1,2), pw2); \
    VRD(6); SBAR(); GAPA(C1=__builtin_amdgcn_mfma_f32_32x32x16_bf16(kf[5],qr[2],C1,0,0,0),   P1[6],P1[7],P1[8],P1[9],     pw2[2]=PKW(P1,4), pw2[3]=PKW(P1,6), pw2); \
    VRD(3); SBAR(); GAPA(C0=__builtin_amdgcn_mfma_f32_32x32x16_bf16(kf[6],qr[3],C0,0,0,0),   P1[10],P1[11],P1[12],P1[13], pw3[0]=PKW(P1,8), pw3[1]=PKW(P1,10), pw3); \
    VRD(7); SBAR(); GAPA(C1=__builtin_amdgcn_mfma_f32_32x32x16_bf16(kf[7],qr[3],C1,0,0,0),   P1[14],P1[15],0.f,0.f,       pw3[2]=PKW(P1,12),pw3[3]=PKW(P1,14), pw3); \
    l_reg+=sacc; \
    if(GK){DMA_K((t)+3,sl_cur);} if(GV){DMA_V((t)+1,sl_next);} \
    CMASK(C0,C1,t); \
    { float a=MX3(C0[0],C0[1],C1[0]),b=MX3(C0[2],C0[3],C1[1]); a=MX3(a,C1[2],C1[3]); \
      _Pragma("unroll") for(int r=4;r<16;r+=4){a=MX3(a,C0[r],C0[r+1]);b=MX3(b,C0[r+2],C0[r+3]);a=MX3(a,C1[r],C1[r+1]);b=MX3(b,C1[r+2],C1[r+3]);} \
      float rm=__builtin_fmaxf(a,b); { auto rr=__builtin_amdgcn_permlane32_swap(__float_as_uint(rm),__float_as_uint(rm),false,false); rm=__builtin_fmaxf(__uint_as_float(rr[0]),__uint_as_float(rr[1])); } \
      resc=false; \
      if(__builtin_expect(__any(rm>(float)THRL),0)){ const float dl=__builtin_fmaxf(rm,0.f); mhat+=dl; \
        _Pragma("unroll") for(int r=0;r<16;++r){C0[r]-=dl;C1[r]-=dl;} \
        _Pragma("unroll") for(int r=0;r<16;++r)negm[r]=-mhat; asm volatile("":"+v"(negm)); \
        const float f=__builtin_amdgcn_exp2f(-dl); l_reg*=f; if(hi==0)wsf[r32]=f; resc=true; } } \
    SBAR(); \
    GAPB(o[0]=__builtin_amdgcn_mfma_f32_32x32x16_bf16(PAF(0),VFR(0),o[0],0,0,0), C0,0); \
    GAPB(o[1]=__builtin_amdgcn_mfma_f32_32x32x16_bf16(PAF(0),VFR(4),o[1],0,0,0), C0,4); \
    KRD(GL,0); GAPB(o[0]=__builtin_amdgcn_mfma_f32_32x32x16_bf16(PAF(1),VFR(1),o[0],0,0,0), C0,8); \
    KRD(GL,1); GAPB(o[1]=__builtin_amdgcn_mfma_f32_32x32x16_bf16(PAF(1),VFR(5),o[1],0,0,0), C0,12); \
    KRD(GL,2); GAPB(o[0]=__builtin_amdgcn_mfma_f32_32x32x16_bf16(PAF(2),VFR(2),o[0],0,0,0), C1,0); \
    KRD(GL,3); GAPB(o[1]=__builtin_amdgcn_mfma_f32_32x32x16_bf16(PAF(2),VFR(6),o[1],0,0,0), C1,4); \
    GAPB(o[0]=__builtin_amdgcn_mfma_f32_32x32x16_bf16(PAF(3),VFR(3),o[0],0,0,0), C1,8); \
    GAPB(o[1]=__builtin_amdgcn_mfma_f32_32x32x16_bf16(PAF(3),VFR(7),o[1],0,0,0), C1,12); \
    }while(0)
  int t=1;
  #undef CMASK
  #define CMASK(P0,P1,t) do{}while(0)
  for(;t+5<NT;t+=2){
    STEP(pB0,pB1,pA0,pA1,t,true,true,true);     WAIT_BAR(2); RESC(); ROT();
    STEP(pA0,pA1,pB0,pB1,t+1,true,true,true);   WAIT_BAR(2); RESC(); ROT();
  }
  #undef CMASK
  #define CMASK(P0,P1,t) do{int jb_=(t)-(NT-4); if(jb_>=0)kmask(P0,P1,(t),hi);}while(0)
  #define ENDW(tt) do{ if((tt)+3<NT){WAIT_BAR(2);} else if((tt)+2<NT){WAIT_BAR(1);} else {WAIT_BAR(0);} }while(0)
  for(;t+1<NT;t+=2){
    STEP(pB0,pB1,pA0,pA1,t,(t+3<NT),(t+1<NT),(t+1<NT));       ENDW(t);   RESC(); ROT();
    STEP(pA0,pA1,pB0,pB1,t+1,(t+4<NT),(t+2<NT),(t+2<NT));     ENDW(t+1); RESC(); ROT();
  }
  STEP(pB0,pB1,pA0,pA1,NT-1,false,false,false); RESC();
  { float sacc=pB0[0]+pB0[1]; _Pragma("unroll") for(int r=2;r<16;++r)sacc+=pB0[r]; _Pragma("unroll") for(int r=0;r<16;++r)sacc+=pB1[r]; l_reg+=sacc;
    pw0=(u32x4){PKW(pB0,0),PKW(pB0,2),PKW(pB0,4),PKW(pB0,6)};pw1=(u32x4){PKW(pB0,8),PKW(pB0,10),PKW(pB0,12),PKW(pB0,14)};pw2=(u32x4){PKW(pB1,0),PKW(pB1,2),PKW(pB1,4),PKW(pB1,6)};pw3=(u32x4){PKW(pB1,8),PKW(pB1,10),PKW(pB1,12),PKW(pB1,14)};
    SBAR(); pv(o,vb0+sl_cur,PAF(0),PAF(1),PAF(2),PAF(3)); }
  #undef PKW
  #undef PAF
  #undef VFR
  #undef PIN
  #undef MX3
  #undef GAPA
  #undef GAPB
  #undef EX
  #undef VRD
  #undef KRD
  #undef STEP
  #undef ENDW
  {auto rr=__builtin_amdgcn_permlane32_swap(__float_as_uint(l_reg),__float_as_uint(l_reg),false,false);l_reg=__uint_as_float(rr[0])+__uint_as_float(rr[1]);}
  if(hi==0)wsf[32+r32]=l_reg;asm volatile("s_waitcnt lgkmcnt(0)":::"memory");
  float rli[16];
  #pragma unroll
  for(int r=0;r<16;++r)rli[r]=__builtin_amdgcn_rcpf(wsf[32+crow(r,hi)]);
  bf16*Ow=O+(rowbase+q0+wid*QBLK)*DM+h*D;
  { bf16*stg=(bf16*)(shm+LDS_OST)+wid*2048;
    #pragma unroll
    for(int r=0;r<16;++r){const int orow=crow(r,hi);
      #pragma unroll
      for(int d0=0;d0<2;++d0)stg[orow*64+d0*32+r32]=__float2bfloat16(o[d0][r]*rli[r]);}
    asm volatile("s_waitcnt lgkmcnt(0)":::"memory");
    #pragma unroll
    for(int i=0;i<4;++i){const int row=i*8+(lane>>3),ch=lane&7; const u32x4 v=*(const u32x4*)(stg+row*64+ch*8); ATTN_STORE16(Ow+(long)row*DM+ch*8,v);} }
  asm volatile("s_waitcnt lgkmcnt(0)\n\ts_barrier":::"memory");
  #undef DMA_K
  #undef DMA_V
  #undef CMASK
  #undef START
  #undef RESC
  #undef ROT
}
constexpr int ATTN_LDS_BYTES=LDS_BYTES;
struct AttnTensors { const bf16* Q; const bf16* K; const bf16* V; bf16* O; };
struct AttnUnit { int bh; int qb; };
struct StaticOrder {
  int vcu, G;
  __device__ __forceinline__ explicit StaticOrder(int grid,int block):vcu((grid%8==0)?(block%8)*(grid/8)+block/8:block),G(grid){}
  __device__ __forceinline__ bool next(int i,AttnUnit&u)const{ const int per=(512+G-1)/G; if(i>=per)return false; const int idx=vcu*per+i; if(idx>=512)return false; u.bh=idx>>4; u.qb=idx&15; return true; }
  __device__ __forceinline__ void a_ready(const AttnUnit&)const{}
  __device__ __forceinline__ void done(const AttnUnit&)const{}
};
template<class Sched,int THRL=8> __device__ __forceinline__ void attn_phase(char*lds,const AttnTensors&T,const Sched&S){
  AttnUnit u;
  for(int i=0;S.next(i,u);++i){ S.a_ready(u); attn_unit<THRL>(u.bh/NHEAD,u.bh%NHEAD,u.qb,T.Q,T.K,T.V,T.O,lds); S.done(u); }
}
#undef SBAR
#undef WAIT_BAR
}
constexpr int NB = 4, SEQ = 4096, NMETA = 16, LSEQ = SEQ + NMETA  , DMODEL = 1024, DFF = 4096;
constexpr int MR = NB * SEQ;
constexpr int MP = 16640;
constexpr int RW = 512;
constexpr int KSEQ = 4224;
constexpr size_t MiB = 1u << 20;
constexpr size_t WS_ROWSS = 0;
constexpr size_t WS_BAR = 512 * 1024;
constexpr size_t WS_WIN = 1 * MiB;
constexpr size_t WS_WG = 7 * MiB;
constexpr size_t WS_WA = 11 * MiB, WS_WB = 12 * MiB;
constexpr size_t WS_WO = 13 * MiB;
constexpr size_t WS_W1 = 15 * MiB;
constexpr size_t WS_W2 = 23 * MiB;
constexpr size_t WS_LW2 = 31 * MiB, WS_LA2 = WS_LW2 + 256 * 1024, WS_LG2 = WS_LW2 + 512 * 1024;
constexpr size_t WS_U = 32 * MiB;
constexpr size_t WS_PRWKV = 65 * MiB;
constexpr size_t WS_E = 65 * MiB, WS_A = WS_E + (size_t)MP * 1024 * 2;
constexpr size_t WS_SG = 65 * MiB;
constexpr size_t WS_PQ = 130 * MiB;
constexpr size_t WS_PKV = 147 * MiB;
constexpr size_t WS_KB = 156 * MiB, WS_VB = 161 * MiB;
constexpr size_t WS_LIN = 166 * MiB;
constexpr size_t WS_G = 183 * MiB;
constexpr size_t WS_YF = 200 * MiB, WS_YB = 216 * MiB;
constexpr size_t WS_YA = 232 * MiB;
constexpr size_t WS_T1 = 166 * MiB;
constexpr size_t WS_MG = 200 * MiB;
constexpr size_t WS_HN = 166 * MiB;
constexpr size_t WS_HID = 32 * MiB;
constexpr size_t WS_END = 256 * MiB;
constexpr size_t DO_R = 0, DO_K = (size_t)MP * 512 * 2, DO_V = 2 * (size_t)MP * 512 * 2;
constexpr int RING_BYTES = 131072, LDS_BYTES = 147456;

#define GAS __attribute__((address_space(1)))
#define LAS __attribute__((address_space(3)))
typedef unsigned short bf16;
typedef unsigned v4u __attribute__((ext_vector_type(4)));
typedef unsigned v2u __attribute__((ext_vector_type(2)));
typedef float f32x4 __attribute__((ext_vector_type(4)));
typedef float f32x2 __attribute__((ext_vector_type(2)));
#define LDS_WAIT() asm volatile("s_waitcnt lgkmcnt(0)" ::: "memory")
__device__ __forceinline__ unsigned f2bf(float f) { unsigned u = __builtin_bit_cast(unsigned, f); return (u + 0x7fffu + ((u >> 16) & 1u)) >> 16; }
__device__ __forceinline__ unsigned pk2(float lo, float hi) { return pg8::cvt_pk_bf16(lo, hi); }
__device__ __forceinline__ float bflo(unsigned w) { return __uint_as_float(w << 16); }
__device__ __forceinline__ float bfhi(unsigned w) { return __uint_as_float(w & 0xffff0000u); }
__device__ __forceinline__ void unpack8(const v4u w, float* f) { f[0] = bflo(w.x); f[1] = bfhi(w.x); f[2] = bflo(w.y); f[3] = bfhi(w.y); f[4] = bflo(w.z); f[5] = bfhi(w.z); f[6] = bflo(w.w); f[7] = bfhi(w.w); }
__device__ __forceinline__ v4u pack8(const float* f) { v4u w; w.x = pk2(f[0], f[1]); w.y = pk2(f[2], f[3]); w.z = pk2(f[4], f[5]); w.w = pk2(f[6], f[7]); return w; }
__device__ __forceinline__ float sigm(float x) { return __builtin_amdgcn_rcpf(1.0f + __expf(-x)); }
__device__ __forceinline__ float wave_sum(float v) {
#pragma unroll
    for (int o = 1; o < 64; o <<= 1) v += __shfl_xor(v, o);
    return v;
}
__device__ __forceinline__ float sum8(float v) { v += __shfl_xor(v, 1); v += __shfl_xor(v, 2); v += __shfl_xor(v, 4); return v; }

struct Args { const float* in[24]; float* out; unsigned char* ws; };

__device__ __forceinline__ void transpose_item(const float* W, int ldw, int ncols, bf16* WT, int ldt, const float* kscale, LAS float* scr, int item, int lane) {
    const int nblk = ncols / 32, kb = item / nblk, nb = item % nblk, k0 = 64 * kb, n0 = 32 * nb;
#pragma unroll 8
    for (int i = 0; i < 32; ++i) { const int kk = 2 * i + (lane >> 5); float v = W[(size_t)(k0 + kk) * ldw + n0 + (lane & 31)]; if (kscale) v *= kscale[k0 + kk]; scr[kk * 33 + (lane & 31)] = v; }
    LDS_WAIT(); asm volatile("" ::: "memory");
    const int c = lane & 7;
#pragma unroll
    for (int j = 0; j < 4; ++j) { const int n = (lane >> 3) + 8 * j; const LAS float* s = scr + (8 * c) * 33 + n;
        v4u o; o.x = pk2(s[0 * 33], s[1 * 33]); o.y = pk2(s[2 * 33], s[3 * 33]); o.z = pk2(s[4 * 33], s[5 * 33]); o.w = pk2(s[6 * 33], s[7 * 33]);
        *(GAS v4u*)(WT + (size_t)(n0 + n) * ldt + k0 + 8 * c) = o; }
    LDS_WAIT(); asm volatile("" ::: "memory");
}

__device__ __forceinline__ void ph0_prologue(const Args& a, LAS unsigned char* lds, int gw, int NGW, int wave, int lane) {
    unsigned char* ws = a.ws;
    const int gt = gw * 64 + lane, NGT = NGW * 64;
    float* rowss = (float*)(ws + WS_ROWSS);
    for (int i = gt; i < 2 * MR; i += NGT) rowss[i] = 0.f;
    LAS float* scr = (LAS float*)(lds + wave * 16384);
    const float* w_in = a.in[3];
    constexpr int I0 = 16 * 61, I1 = 16 * 24, I2 = 16 * 64, I3 = 8 * 32, I4 = 8 * 32, I5 = 16 * 32, I6 = 16 * 128, I7 = 64 * 32;
    constexpr int NIT = I0 + I1 + I2 + I3 + I4 + I5 + I6 + I7;
    for (int it = gw; it < NIT; it += NGW) {
        int r = it;
        if (r < I0) { transpose_item(w_in, 4768, 1952, (bf16*)(ws + WS_WIN), 1024, nullptr, scr, r, lane); continue; } r -= I0;
        if (r < I1) { transpose_item(w_in + 1952, 4768, 768, (bf16*)(ws + WS_WIN) + (size_t)2048 * 1024, 1024, nullptr, scr, r, lane); continue; } r -= I1;
        if (r < I2) { transpose_item(w_in + 2720, 4768, 2048, (bf16*)(ws + WS_WG), 1024, nullptr, scr, r, lane); continue; } r -= I2;
        if (r < I3) { transpose_item(a.in[17], 1024, 1024, (bf16*)(ws + WS_WA), 512, nullptr, scr, r, lane); continue; } r -= I3;
        if (r < I4) { transpose_item(a.in[18], 1024, 1024, (bf16*)(ws + WS_WB), 512, nullptr, scr, r, lane); continue; } r -= I4;
        if (r < I5) { transpose_item(a.in[19], 1024, 1024, (bf16*)(ws + WS_WO), 1024, nullptr, scr, r, lane); continue; } r -= I5;
        if (r < I6) { transpose_item(a.in[21], 4096, 4096, (bf16*)(ws + WS_W1), 1024, a.in[20], scr, r, lane); continue; } r -= I6;
        transpose_item(a.in[22], 1024, 1024, (bf16*)(ws + WS_W2), 4096, nullptr, scr, r, lane);
    }
    { bf16* p = (bf16*)(ws + WS_WIN) + (size_t)1952 * 1024; for (int i = gt; i < 96 * 1024 / 2; i += NGT) ((unsigned*)p)[i] = 0u; }
    { bf16* lw = (bf16*)(ws + WS_LW2); bf16* la = (bf16*)(ws + WS_LA2); bf16* lg = (bf16*)(ws + WS_LG2);
      const float* w2 = a.in[6]; const float* a2 = a.in[8]; const float* g2 = a.in[9];
      for (int i = gt; i < 1024 * 128; i += NGT) { const int row = i >> 7, col = i & 127, d = row >> 9, n = row & 511, kd = col >> 6, k = col & 63;
          float v1 = 0.f, v2 = 0.f; if (kd == d) { v1 = w2[((size_t)d * 64 + k) * 512 + n]; v2 = a2[((size_t)d * 64 + k) * 512 + n]; }
          lw[i] = (bf16)f2bf(v1); la[i] = (bf16)f2bf(v2); }
      for (int i = gt; i < 512 * 256; i += NGT) { const int n = i >> 8, k = i & 255; lg[i] = (bf16)f2bf(k < 160 ? g2[(size_t)k * 512 + n] : 0.f); } }
    { for (int i = gt; i < 2 * NB * 112 * 64; i += NGT) { const int arr = i / (NB * 112 * 64), r = i % (NB * 112 * 64), b = r / (112 * 64), o = r % (112 * 64);
          ((unsigned*)(ws + (arr ? WS_VB : WS_KB)))[((size_t)b * KSEQ + LSEQ) * 64 + o] = 0u; } }
    const float* g = a.in[2];
    for (int m = gw; m < MP; m += NGW) {
        bf16* orow = (bf16*)(ws + WS_U) + (size_t)m * 1024;
        GAS unsigned long long* o8 = (GAS unsigned long long*)orow + lane;
        if (m >= MR + NMETA) {
#pragma unroll
            for (int j = 0; j < 4; ++j) o8[64 * j] = 0ull;
            continue; }
        const float* xrow = (m < MR) ? a.in[0] + (size_t)m * 1024 : a.in[1] + (size_t)(m - MR) * 1024;
        const GAS f32x4* xr = (const GAS f32x4*)xrow + lane;
        f32x4 v[4]; float s = 0.f;
#pragma unroll
        for (int j = 0; j < 4; ++j) { v[j] = xr[64 * j]; s += (v[j].x * v[j].x + v[j].y * v[j].y) + (v[j].z * v[j].z + v[j].w * v[j].w); }
        const float rstd = rsqrtf(wave_sum(s) * (1.f / 1024.f) + 1e-6f);
#pragma unroll
        for (int j = 0; j < 4; ++j) { const f32x4 gg = *((const f32x4*)g + lane + 64 * j); const f32x4 y = v[j] * rstd * gg;
            o8[64 * j] = (unsigned long long)pk2(y.x, y.y) | ((unsigned long long)pk2(y.z, y.w) << 32); }
    }
}

__device__ __forceinline__ int prow(int b, int pos) { return pos < NMETA ? MR + pos : b * SEQ + pos - NMETA; }

__device__ __forceinline__ void ph2_prep(const Args& a, int gw, int NGW, int lane) {
    unsigned char* ws = a.ws;
    const bf16* P = (const bf16*)(ws + WS_PRWKV);
    bf16* R = (bf16*)((unsigned char*)a.out + DO_R); bf16* K = (bf16*)((unsigned char*)a.out + DO_K); bf16* V = (bf16*)((unsigned char*)a.out + DO_V);
    bf16* LIN = (bf16*)(ws + WS_LIN);
    const float* mu = a.in[4];
    bf16* PQ = (bf16*)(ws + WS_PQ); const bf16* PKV = (const bf16*)(ws + WS_PKV);
    bf16* KBp = (bf16*)(ws + WS_KB); bf16* VBp = (bf16*)(ws + WS_VB);
    const float* qg = a.in[15]; const float* kg = a.in[16];
    const int l8 = lane & 7; const int axis = l8 >> 2, half = (l8 >> 1) & 1, f0 = (l8 & 1) * 8;
    float cfreq[8];
#pragma unroll
    for (int j = 0; j < 8; ++j) cfreq[j] = exp2f(-(float)(f0 + j) * (13.287712379549449f / 16.0f)) * 0.15915494309189535f;
    float qgl[8], kgl[8];
#pragma unroll
    for (int j = 0; j < 8; ++j) { qgl[j] = qg[l8 * 8 + j]; kgl[j] = kg[l8 * 8 + j]; }
    constexpr float C2 = 0.125f * 1.4426950408889634f;
    for (int s = gw; s < NB * LSEQ; s += NGW) {
        const int b = s / LSEQ, pos = s % LSEQ;
        const int rc = prow(b, pos), rp = pos > 0 ? prow(b, pos - 1) : -1, rn = pos < LSEQ - 1 ? prow(b, pos + 1) : -1;
#pragma unroll
        for (int it = 0; it < 4; ++it) {
            const int col0 = it * 512 + lane * 8;
            float z[8];
            if (col0 < 1952) {
                float pc[8], pp[8], pn[8];
                unpack8(*(const v4u*)(P + (size_t)rc * 2048 + col0), pc);
                if (rp >= 0) unpack8(*(const v4u*)(P + (size_t)rp * 2048 + col0), pp); else {
#pragma unroll
                    for (int j = 0; j < 8; ++j) pp[j] = 0.f; }
                if (rn >= 0) unpack8(*(const v4u*)(P + (size_t)rn * 2048 + col0), pn); else {
#pragma unroll
                    for (int j = 0; j < 8; ++j) pn[j] = 0.f; }
                const f32x4 m0a = *(const f32x4*)(mu + col0), m0b = *(const f32x4*)(mu + col0 + 4), m1a = *(const f32x4*)(mu + 1952 + col0), m1b = *(const f32x4*)(mu + 1952 + col0 + 4);
#pragma unroll
                for (int j = 0; j < 8; ++j) { const float m0 = j < 4 ? m0a[j & 3] : m0b[j & 3], m1 = j < 4 ? m1a[j & 3] : m1b[j & 3]; z[j] = pc[j] + m0 * (pp[j] - pc[j]) + m1 * (pn[j] - pc[j]); }
            } else {
#pragma unroll
                for (int j = 0; j < 8; ++j) z[j] = 0.f; }
            if (it < 3) { bf16* dst = (it == 0 ? R : it == 1 ? K : V) + (size_t)s * 512 + lane * 8; *(v4u*)dst = pack8(z); }
            else { const int c = lane * 8;
                if (c < 128) {
#pragma unroll
                    for (int j = 0; j < 8; ++j) z[j] = 1.0f - 2.0f * __builtin_amdgcn_rcpf(__expf(2.0f * z[j]) + 1.0f); }
                else if (c >= 256 && c < 416) {
#pragma unroll
                    for (int j = 0; j < 8; ++j) z[j] = sigm(z[j]); }
                else if (c >= 416) {
#pragma unroll
                    for (int j = 0; j < 8; ++j) z[j] = 0.f; }
                *(v4u*)(LIN + (size_t)s * 512 + c) = pack8(z); }
        }
        float cs[8], sn[8];
        { const int t = pos - NMETA; const float coord = (t < 0) ? 0.f : (float)(axis == 0 ? (t >> 6) : (t & 63));
#pragma unroll
          for (int j = 0; j < 8; ++j) { float rev = coord * cfreq[j]; rev -= floorf(rev); cs[j] = __builtin_amdgcn_cosf(rev); sn[j] = __builtin_amdgcn_sinf(rev); } }
        if (pos >= NMETA) {
            bf16* qp = PQ + (size_t)rc * 512 + lane * 8; float x[8], xp[8];
            unpack8(*(const v4u*)qp, x);
            float ss = 0.f;
#pragma unroll
            for (int j = 0; j < 8; ++j) ss += x[j] * x[j];
            const float rs = rsqrtf(sum8(ss) * (1.f / 64.f) + 1e-6f);
#pragma unroll
            for (int j = 0; j < 8; ++j) { x[j] = x[j] * rs * qgl[j]; }
#pragma unroll
            for (int j = 0; j < 8; ++j) xp[j] = __shfl_xor(x[j], 2);
            float o[8];
#pragma unroll
            for (int j = 0; j < 8; ++j) o[j] = (half == 0 ? x[j] * cs[j] - xp[j] * sn[j] : x[j] * cs[j] + xp[j] * sn[j]) * C2;
            *(v4u*)qp = pack8(o);
        }
        {
            const int slot = pos >= NMETA ? pos - NMETA : SEQ + pos;
            if (lane < 32) {
                float x[8], xp[8];
                unpack8(*(const v4u*)(PKV + (size_t)rc * 256 + lane * 8), x);
                float ss = 0.f;
#pragma unroll
                for (int j = 0; j < 8; ++j) ss += x[j] * x[j];
                const float rs = rsqrtf(sum8(ss) * (1.f / 64.f) + 1e-6f);
                float xn[8];
#pragma unroll
                for (int j = 0; j < 8; ++j) xn[j] = x[j] * rs * kgl[j];
#pragma unroll
                for (int j = 0; j < 8; ++j) xp[j] = __shfl_xor(xn[j], 2);
                float o[8];
#pragma unroll
                for (int j = 0; j < 8; ++j) o[j] = (half == 0 ? xn[j] * cs[j] - xp[j] * sn[j] : xn[j] * cs[j] + xp[j] * sn[j]);
                if (lane < 16) *(v4u*)(KBp + ((size_t)b * KSEQ + slot) * 128 + lane * 8) = pack8(o);
                else *(v4u*)(VBp + ((size_t)b * KSEQ + slot) * 128 + (lane - 16) * 8) = pack8(x);
            }
        }
    }
}

__device__ __forceinline__ void ph5_post(const Args& a, int gw, int NGW, int lane) {
    unsigned char* ws = a.ws;
    const bf16* R = (const bf16*)((unsigned char*)a.out + DO_R); const bf16* K = (const bf16*)((unsigned char*)a.out + DO_K); const bf16* V = (const bf16*)((unsigned char*)a.out + DO_V);
    const bf16* A = (const bf16*)(ws + WS_A); const bf16* G = (const bf16*)(ws + WS_G);
    const bf16* YF = (const bf16*)(ws + WS_YF); const bf16* YB = (const bf16*)(ws + WS_YB); bf16* YA = (bf16*)(ws + WS_YA);
    const int c0 = lane * 8;
    float ka[8], rk[8], lg[8], lb[8];
#pragma unroll
    for (int j = 0; j < 8; ++j) { ka[j] = a.in[11][c0 + j]; rk[j] = a.in[12][c0 + j]; lg[j] = a.in[13][c0 + j]; lb[j] = a.in[14][c0 + j]; }
    for (int row = gw; row < MR; row += NGW) {
        const int b = row >> 12, t = row & 4095; const size_t s = (size_t)b * LSEQ + t + NMETA;
        float yf[8], yb[8], r[8], k[8], v[8], a0[8], a1[8], g[8], y[8];
        { const size_t yo = ((((size_t)(b * 8 + (lane >> 3)) * 4 + ((lane & 7) >> 1)) * SEQ + t) * 16 + (lane & 1) * 8);
          unpack8(*(const v4u*)(YF + yo), yf); unpack8(*(const v4u*)(YB + yo), yb); }
        unpack8(*(const v4u*)(R + s * 512 + c0), r); unpack8(*(const v4u*)(K + s * 512 + c0), k); unpack8(*(const v4u*)(V + s * 512 + c0), v);
        unpack8(*(const v4u*)(A + s * 1024 + c0), a0); unpack8(*(const v4u*)(A + s * 1024 + 512 + c0), a1); unpack8(*(const v4u*)(G + s * 512 + c0), g);
        float sm = 0.f;
#pragma unroll
        for (int j = 0; j < 8; ++j) { y[j] = yf[j] + yb[j]; sm += y[j]; }
        const float mean = sum8(sm) * (1.f / 64.f); float sq = 0.f;
#pragma unroll
        for (int j = 0; j < 8; ++j) { y[j] -= mean; sq += y[j] * y[j]; }
        const float rstd = rsqrtf(sum8(sq) * (1.f / 64.f) + 64e-5f);
        float dt = 0.f;
#pragma unroll
        for (int j = 0; j < 8; ++j) { const float kh = k[j] * (1.0f + ((a0[j] + a1[j]) * 0.5f - 1.0f) * ka[j]); dt += r[j] * kh * rk[j]; }
        dt = sum8(dt);
        float o[8];
#pragma unroll
        for (int j = 0; j < 8; ++j) o[j] = (y[j] * rstd * lg[j] + lb[j] + dt * v[j]) * g[j];
        *(v4u*)(YA + (size_t)row * 512 + c0) = pack8(o);
    }
}

__device__ __forceinline__ void ph10_final(const Args& a, int gw, int NGW, int lane) {
    const float* rowss2 = (const float*)(a.ws + WS_ROWSS) + MR; const float* g = a.in[23];
    f32x4 gg[4];
#pragma unroll
    for (int j = 0; j < 4; ++j) gg[j] = *((const f32x4*)g + lane + 64 * j);
    for (int row = gw; row < MR; row += NGW) {
        const float rs = rsqrtf(rowss2[row] * (1.f / 1024.f) + 1e-6f);
        GAS f32x4* p = (GAS f32x4*)(a.out + (size_t)row * 1024) + lane;
#pragma unroll
        for (int j = 0; j < 4; ++j) p[64 * j] = p[64 * j] * rs * gg[j];
    }
}
#define XB_TMO      128
#define XB_XCNT(j)  (256  + 64 * (j))
#define XB_XSUB(j)  (1280 + 64 * (j))
#define XB_XGEN(j)  (2304 + 64 * (j))
#define XB_TOP      3328
#define XB_TOPGEN   3392
#define XCD_BAR_WORDS 3456
#define XB_SPIN_CAP (1u << 18)

__device__ __forceinline__ unsigned xb_ld(unsigned* p)              { return __hip_atomic_load(p, __ATOMIC_RELAXED, __HIP_MEMORY_SCOPE_AGENT); }
__device__ __forceinline__ unsigned xb_add(unsigned* p, unsigned v) { return __hip_atomic_fetch_add(p, v, __ATOMIC_RELAXED, __HIP_MEMORY_SCOPE_AGENT); }
__device__ __forceinline__ unsigned xb_xcc_id() { return (unsigned)__builtin_amdgcn_s_getreg((3 << 11) | 20) & 0xFu; }
#define XB_SPIN(cond, bar) do { unsigned _sp = 0; while (cond) { __builtin_amdgcn_s_sleep(1); \
    if ((++_sp & 255u) == 0u) { if (xb_ld(&(bar)[XB_TMO])) break; if (_sp > XB_SPIN_CAP) { atomicAdd(&(bar)[XB_TMO], 1u); break; } } } } while (0)

struct XcdBarrier {
    unsigned* bar; unsigned x;
    volatile LAS unsigned* st;
};

__device__ __forceinline__ XcdBarrier xcd_barrier_post(unsigned* bar, volatile LAS unsigned* st) {
    XcdBarrier b; b.bar = bar; b.x = xb_xcc_id(); b.st = st;
    if (threadIdx.x == 0) (void)xb_add(&bar[XB_XCNT(b.x)], 1u);
    return b;
}
__device__ __forceinline__ void xcd_barrier_complete(unsigned* bar, unsigned x, unsigned& nloc, unsigned& nx) {
    const unsigned G = gridDim.x * gridDim.y * gridDim.z;
    unsigned sum, cnt, mine, sp = 0u;
    for (;;) {
        sum = 0u; cnt = 0u; mine = 0u;
#pragma unroll
        for (unsigned j = 0; j < 16; ++j) { const unsigned c = xb_ld(&bar[XB_XCNT(j)]); sum += c; cnt += (c > 0u) ? 1u : 0u; mine = (j == x) ? c : mine; }
        if (sum == G) break;
        __builtin_amdgcn_s_sleep(1);
        if ((++sp & 255u) == 0u) { if (xb_ld(&bar[XB_TMO])) break; if (sp > XB_SPIN_CAP) { atomicAdd(&bar[XB_TMO], 1u); break; } }
    }
    nloc = mine > 0u ? mine : 1u; nx = cnt > 0u ? cnt : 1u;
}

__device__ __forceinline__ void xcd_barrier(const XcdBarrier& b) {
    asm volatile("s_waitcnt vmcnt(0)" ::: "memory");
    __syncthreads();
    if (threadIdx.x == 0) {
        unsigned* bar = b.bar;
        __builtin_amdgcn_s_waitcnt(0);
        unsigned nloc = b.st[0], nx = b.st[1];
        if (nloc == 0u) { xcd_barrier_complete(bar, b.x, nloc, nx); b.st[0] = nloc; b.st[1] = nx; }
        const unsigned old = xb_add(&bar[XB_XSUB(b.x)], 1u);
        const unsigned gen = old / nloc;
        if (old + 1u == (gen + 1u) * nloc) {
            __builtin_amdgcn_fence(__ATOMIC_RELEASE, "agent");
            asm volatile("s_waitcnt vmcnt(0)" ::: "memory");
            const unsigned og = xb_add(&bar[XB_TOP], 1u);
            const unsigned tg = og / nx;
            if (og + 1u == (tg + 1u) * nx) xb_add(&bar[XB_TOPGEN], 1u);
            else XB_SPIN(xb_ld(&bar[XB_TOPGEN]) == tg, bar);
            __builtin_amdgcn_fence(__ATOMIC_ACQUIRE, "agent");
            xb_add(&bar[XB_XGEN(b.x)], 1u);
            asm volatile("s_waitcnt vmcnt(0)" ::: "memory");
        } else {
            XB_SPIN(xb_ld(&bar[XB_XGEN(b.x)]) == gen, bar);
            __builtin_amdgcn_fence(__ATOMIC_ACQUIRE, "agent");
            asm volatile("s_waitcnt vmcnt(0)" ::: "memory");
        }
    }
    __syncthreads();
}

constexpr int SC_T = 32;
constexpr int SC_ARR = SC_T * 64 * 4;
constexpr int SC_KKN = 0, SC_WR = SC_ARR, SC_W = 2 * SC_ARR, SC_KKA = 3 * SC_ARR, SC_KD = 4 * SC_ARR, SC_VV = 5 * SC_ARR, SC_AB = SC_VV + SC_T * 16 * 4, SC_BUF = SC_AB + SC_T * 8;
constexpr int SC_YB = 2 * SC_BUF, SC_YBSZ = SC_T * 16 * 4;
static_assert(SC_YB + 2 * SC_YBSZ <= RING_BYTES, "scan LDS");
template <int CTRL> __device__ __forceinline__ float dpp_f(float v) { return __uint_as_float(__builtin_amdgcn_update_dpp(0u, __float_as_uint(v), CTRL, 0xf, 0xf, true)); }
__device__ __forceinline__ float red16(float v) { v += dpp_f<0xB1>(v); v += dpp_f<0x4E>(v); v += dpp_f<0x141>(v); v += dpp_f<0x140>(v); return v; }

__device__ __forceinline__ void ph4_scan(const Args& a, LAS unsigned char* lds, int tid, int wave, int lane) {
    unsigned char* ws = a.ws;
    const bf16* R = (const bf16*)((unsigned char*)a.out + DO_R); const bf16* K = (const bf16*)((unsigned char*)a.out + DO_K); const bf16* V = (const bf16*)((unsigned char*)a.out + DO_V);
    const bf16* E = (const bf16*)(ws + WS_E); const bf16* A = (const bf16*)(ws + WS_A);
    for (int unit = blockIdx.x; unit < 256; unit += gridDim.x) {
        const int chain = unit & 63, rg = unit >> 6, dir = chain >> 5, b = (chain >> 3) & 3, h = chain & 7;
        const int nsteps = dir == 0 ? LSEQ : SEQ, nchunks = (nsteps + SC_T - 1) / SC_T;
        bf16* Y = (bf16*)(ws + (dir == 0 ? WS_YF : WS_YB));
        const int q = tid - 256, ts = (q >> 3) & 31, c8 = q & 7, ch0 = h * 64 + c8 * 8;
        float kkc[8], kac[8];
        v4u lr = {0,0,0,0}, lk = lr, lv = lr, le = lr, la = lr;
        if (wave >= 4) {
#pragma unroll
            for (int j = 0; j < 8; ++j) { kkc[j] = a.in[10][ch0 + j]; kac[j] = a.in[11][ch0 + j]; } }
        auto issue = [&](int c) {
            const int tau = c * SC_T + ts;
            if (tau < nsteps) { const int pos = dir == 0 ? tau : LSEQ - 1 - tau; const size_t s = (size_t)b * LSEQ + pos;
                lr = *(const v4u*)(R + s * 512 + ch0); lk = *(const v4u*)(K + s * 512 + ch0); lv = *(const v4u*)(V + s * 512 + ch0);
                le = *(const v4u*)(E + s * 1024 + dir * 512 + ch0); la = *(const v4u*)(A + s * 1024 + dir * 512 + ch0); }
            else { lr = (v4u){0,0,0,0}; lk = lr; lv = lr; le = lr; la = lr; } };
        auto transform = [&](int bufi) {
            LAS unsigned char* B = lds + bufi * SC_BUF;
            float r[8], k[8], v[8], e[8], aa[8]; unpack8(lr, r); unpack8(lk, k); unpack8(lv, v); unpack8(le, e); unpack8(la, aa);
            float w[8], kd[8], kk[8], ss = 0.f;
#pragma unroll
            for (int j = 0; j < 8; ++j) { w[j] = __expf(-e[j]); kd[j] = k[j] * (1.0f + (aa[j] - 1.0f) * kac[j]); kk[j] = k[j] * kkc[j]; ss += kk[j] * kk[j]; }
            ss = sum8(ss); const float inv = 1.0f / fmaxf(sqrtf(ss), 1e-12f);
            float al = 0.f, be = 0.f; float kka[8], wr[8];
#pragma unroll
            for (int j = 0; j < 8; ++j) { kk[j] *= inv; kka[j] = kk[j] * aa[j]; wr[j] = w[j] * r[j]; al += kka[j] * r[j]; be += kd[j] * r[j]; }
            al = sum8(al); be = sum8(be);
            const int o = (ts * 64 + c8 * 8) * 4;
            *(LAS f32x4*)(B + SC_KKN + o) = (f32x4){-kk[0], -kk[1], -kk[2], -kk[3]}; *(LAS f32x4*)(B + SC_KKN + o + 16) = (f32x4){-kk[4], -kk[5], -kk[6], -kk[7]};
            *(LAS f32x4*)(B + SC_WR + o) = (f32x4){wr[0], wr[1], wr[2], wr[3]}; *(LAS f32x4*)(B + SC_WR + o + 16) = (f32x4){wr[4], wr[5], wr[6], wr[7]};
            *(LAS f32x4*)(B + SC_W + o) = (f32x4){w[0], w[1], w[2], w[3]}; *(LAS f32x4*)(B + SC_W + o + 16) = (f32x4){w[4], w[5], w[6], w[7]};
            *(LAS f32x4*)(B + SC_KKA + o) = (f32x4){kka[0], kka[1], kka[2], kka[3]}; *(LAS f32x4*)(B + SC_KKA + o + 16) = (f32x4){kka[4], kka[5], kka[6], kka[7]};
            *(LAS f32x4*)(B + SC_KD + o) = (f32x4){kd[0], kd[1], kd[2], kd[3]}; *(LAS f32x4*)(B + SC_KD + o + 16) = (f32x4){kd[4], kd[5], kd[6], kd[7]};
            if ((c8 >> 1) == rg) { const int vo = (ts * 16 + (c8 & 1) * 8) * 4; *(LAS f32x4*)(B + SC_VV + vo) = (f32x4){v[0], v[1], v[2], v[3]}; *(LAS f32x4*)(B + SC_VV + vo + 16) = (f32x4){v[4], v[5], v[6], v[7]}; }
            if (c8 == 0) *(LAS f32x2*)(B + SC_AB + ts * 8) = (f32x2){al, be}; };
        auto flush = [&](int c) {
            const int tau = c * SC_T + ts;
            if (tau < nsteps) { const int pos = dir == 0 ? tau : LSEQ - 1 - tau;
                if (pos >= NMETA) { const f32x2 yy = *(const LAS f32x2*)(lds + SC_YB + (c & 1) * SC_YBSZ + (ts * 16 + c8 * 2) * 4);
                    *(unsigned*)(Y + ((((size_t)(b * 8 + h) * 4 + rg) * SEQ + (pos - NMETA)) * 16 + c8 * 2)) = pk2(yy.x, yy.y); } } };
        if (wave >= 4) { issue(0); transform(0); if (nchunks > 1) issue(1); }
        __syncthreads();
        f32x4 S = {0.f, 0.f, 0.f, 0.f};
        const int r4 = lane >> 4, cgp = lane & 15, vrow = wave * 4 + r4;
        for (int c = 0; c < nchunks; ++c) {
            if (wave < 4) {
                const int n = min(SC_T, nsteps - c * SC_T);
                LAS unsigned char* B = lds + (c & 1) * SC_BUF;
                LAS float* yb = (LAS float*)(lds + SC_YB + (c & 1) * SC_YBSZ);
                for (int t = 0; t < n; ++t) {
                    const int o = (t * 64 + cgp * 4) * 4;
                    const f32x4 kkn = *(const LAS f32x4*)(B + SC_KKN + o), wr = *(const LAS f32x4*)(B + SC_WR + o), w4 = *(const LAS f32x4*)(B + SC_W + o),
                                kka = *(const LAS f32x4*)(B + SC_KKA + o), kd = *(const LAS f32x4*)(B + SC_KD + o);
                    const float vv = *(const LAS float*)(B + SC_VV + (t * 16 + vrow) * 4); const f32x2 ab = *(const LAS f32x2*)(B + SC_AB + t * 8);
                    const f32x4 p1 = S * kkn, p2 = S * wr;
                    float sa = (p1[0] + p1[1]) + (p1[2] + p1[3]), yp = (p2[0] + p2[1]) + (p2[2] + p2[3]);
                    sa = red16(sa); yp = red16(yp);
                    S = S * w4 + (kka * sa + kd * vv);
                    const float y = yp + sa * ab.x + vv * ab.y;
                    if (cgp == 0) yb[t * 16 + vrow] = y;
                }
            } else {
                if (c + 1 < nchunks) transform((c + 1) & 1);
                if (c + 2 < nchunks) issue(c + 2);
                if (c >= 1) flush(c - 1);
            }
            __syncthreads();
        }
        if (wave >= 4) flush(nchunks - 1);
        __syncthreads();
    }
}
__global__ void __launch_bounds__(512, 2) fwd_kernel(Args a) {
    extern __shared__ __attribute__((aligned(16))) unsigned char lds_raw[];
    cg::grid_group grid = cg::this_grid();
#define GSYNC() do { xcd_barrier(bar); } while (0)
    LAS unsigned char* lds = (LAS unsigned char*)lds_raw;
    if (threadIdx.x < 32) ((LAS unsigned*)(lds + RING_BYTES))[threadIdx.x] = 0u;
    __syncthreads();
    XcdBarrier bar = xcd_barrier_post((unsigned*)(a.ws + WS_BAR), (volatile LAS unsigned*)(lds + RING_BYTES) + 8);
    grid.sync();
    const int G = gridDim.x, bx = blockIdx.x;
    const int NGW = G * 8;
    unsigned char* ws = a.ws;
    float* rowss1 = (float*)(ws + WS_ROWSS); float* rowss2 = rowss1 + MR;
    { const int t_ = otid(), w_ = __builtin_amdgcn_readfirstlane(t_ >> 6); ph0_prologue(a, lds, bx * 8 + w_, NGW, w_, t_ & 63); }
    GSYNC();
    { pg8::Gemm g{(const bf16*)(ws + WS_U), (const bf16*)(ws + WS_WIN), MP, 2816, 1024, 1024, 1024}; pg8::StaticOrder S; S.init(MP, 2816, G, bx);
      pg8::EpiSplit E{(bf16*)(ws + WS_PRWKV), (bf16*)(ws + WS_PQ), (bf16*)(ws + WS_PKV)};
      pg8::gemm_phase<pg8::EpiSplit, pg8::StaticOrder, true>(lds, g, S, E); }
    GSYNC();
    { const int t_ = otid(), w_ = __builtin_amdgcn_readfirstlane(t_ >> 6); ph2_prep(a, bx * 8 + w_, NGW, t_ & 63); }
    GSYNC();
    { pg8::Gemm g{(const bf16*)(ws + WS_LIN), (const bf16*)(ws + WS_LW2), MP, 1024, 128, 512, 128}; pg8::StaticOrder S; S.init(MP, 1024, G, bx);
      pg8::EpiAct<1, true> E{(bf16*)(ws + WS_E), 1024, a.in[5], 0.6065306597126334f};
      pg8::gemm_phase<pg8::EpiAct<1, true>, pg8::StaticOrder, true>(lds, g, S, E); }
    { pg8::Gemm g{(const bf16*)(ws + WS_LIN) + 128, (const bf16*)(ws + WS_LA2), MP, 1024, 128, 512, 128}; pg8::StaticOrder S; S.init(MP, 1024, G, (bx + 128) % G);
      pg8::EpiAct<1, true> E{(bf16*)(ws + WS_A), 1024, a.in[7], 1.0f};
      pg8::gemm_phase<pg8::EpiAct<1, true>, pg8::StaticOrder, true>(lds, g, S, E); }
    { pg8::Gemm g{(const bf16*)(ws + WS_LIN) + 256, (const bf16*)(ws + WS_LG2), MP, 512, 256, 512, 256}; pg8::StaticOrder S; S.init(MP, 512, G, (bx + 64) % G);
      pg8::EpiAct<0, false> E{(bf16*)(ws + WS_G), 512, nullptr, 1.0f};
      pg8::gemm_phase<pg8::EpiAct<0, false>, pg8::StaticOrder, true>(lds, g, S, E); }
    GSYNC();
    { const int t_ = otid(), w_ = __builtin_amdgcn_readfirstlane(t_ >> 6); ph4_scan(a, lds, t_, w_, t_ & 63); }
    { const attn_body::AttnTensors AT{(const attn_body::bf16*)(ws + WS_PQ), (const attn_body::bf16*)(ws + WS_KB), (const attn_body::bf16*)(ws + WS_VB), (attn_body::bf16*)(ws + WS_PQ)};
      const attn_body::StaticOrder S(G, bx);
      attn_body::attn_phase<attn_body::StaticOrder>((char*)lds_raw, AT, S); }
    GSYNC();
    { const int t_ = otid(), w_ = __builtin_amdgcn_readfirstlane(t_ >> 6); ph5_post(a, bx * 8 + w_, NGW, t_ & 63); }
    GSYNC();
    { pg8::Gemm g{(const bf16*)(ws + WS_U), (const bf16*)(ws + WS_WG), MR, 2048, 1024, 1024, 1024}; pg8::StaticOrder S; S.init(MR, 2048, G, bx);
      pg8::EpiAct<1, false> E{(bf16*)(ws + WS_SG), 2048, nullptr, 1.0f};
      pg8::gemm_phase<pg8::EpiAct<1, false>, pg8::StaticOrder, true>(lds, g, S, E); }
    GSYNC();
    { pg8::Gemm g{(const bf16*)(ws + WS_YA), (const bf16*)(ws + WS_WA), MR, 1024, 512, 512, 512}; pg8::StaticOrder S; S.init(MR, 1024, G, bx);
      pg8::EpiMul E{(bf16*)(ws + WS_T1), (const bf16*)(ws + WS_SG), 0, nullptr};
      pg8::gemm_phase<pg8::EpiMul, pg8::StaticOrder, true>(lds, g, S, E); }
    { pg8::Gemm g{(const bf16*)(ws + WS_PQ), (const bf16*)(ws + WS_WB), MR, 1024, 512, 512, 512}; pg8::StaticOrder S; S.init(MR, 1024, G, bx);
      pg8::EpiMul E{(bf16*)(ws + WS_MG), (const bf16*)(ws + WS_SG), 1024, (const bf16*)(ws + WS_T1)};
      pg8::gemm_phase<pg8::EpiMul, pg8::StaticOrder, true>(lds, g, S, E); }
    GSYNC();
    { pg8::Gemm g{(const bf16*)(ws + WS_MG), (const bf16*)(ws + WS_WO), MR, 1024, 1024, 1024, 1024}; pg8::StaticOrder S; S.init(MR, 1024, G, bx);
      pg8::EpiRes E{a.in[0], a.out, (bf16*)(ws + WS_HN), rowss1};
      pg8::gemm_phase<pg8::EpiRes, pg8::StaticOrder, true>(lds, g, S, E); }
    GSYNC();
    { pg8::Gemm g{(const bf16*)(ws + WS_HN), (const bf16*)(ws + WS_W1), MR, 4096, 1024, 1024, 1024}; pg8::StaticOrder S; S.init(MR, 4096, G, bx);
      pg8::EpiFF1 E{(bf16*)(ws + WS_HID), rowss1};
      pg8::gemm_phase<pg8::EpiFF1, pg8::StaticOrder, true>(lds, g, S, E); }
    GSYNC();
    { pg8::Gemm g{(const bf16*)(ws + WS_HID), (const bf16*)(ws + WS_W2), MR, 1024, 4096, 4096, 4096}; pg8::StaticOrder S; S.init(MR, 1024, G, bx);
      pg8::EpiRes E{a.out, a.out, nullptr, rowss2};
      pg8::gemm_phase<pg8::EpiRes, pg8::StaticOrder, true>(lds, g, S, E); }
    GSYNC();
    { const int t_ = otid(), w_ = __builtin_amdgcn_readfirstlane(t_ >> 6); ph10_final(a, bx * 8 + w_, NGW, t_ & 63); }
}

extern "C" void kernel_launch(void* const* d_in, const int* in_sizes, int n_in, void* d_out, int out_size, void* d_ws, size_t ws_size, hipStream_t stream) {
    static int grid = 0;
    if (grid == 0) {
        if (n_in != 24 || out_size != MR * DMODEL || ws_size < WS_END) { fprintf(stderr, "kernel_launch: unexpected shapes n_in %d out %d ws %zu\n", n_in, out_size, ws_size); grid = -1; return; }
        int dev = 0, cus = 0, per_cu = 0;
        if (hipGetDevice(&dev) != hipSuccess || hipDeviceGetAttribute(&cus, hipDeviceAttributeMultiprocessorCount, dev) != hipSuccess) { grid = -1; return; }
        if (hipFuncSetAttribute((const void*)fwd_kernel, hipFuncAttributeMaxDynamicSharedMemorySize, LDS_BYTES) != hipSuccess) { fprintf(stderr, "hipFuncSetAttribute failed\n"); grid = -1; return; }
        if (hipOccupancyMaxActiveBlocksPerMultiprocessor(&per_cu, (const void*)fwd_kernel, 512, LDS_BYTES) != hipSuccess || per_cu < 1) { fprintf(stderr, "occupancy query: %d\n", per_cu); }
        (void)hipGetLastError();
        grid = cus;
    }
    if (grid < 0) return;
    if (hipMemsetAsync((char*)d_ws + WS_BAR, 0, 16384, stream) != hipSuccess) { fprintf(stderr, "memset failed\n"); return; }
    Args a{};
    for (int i = 0; i < 24; ++i) a.in[i] = (const float*)d_in[i];
    a.out = (float*)d_out; a.ws = (unsigned char*)d_ws;
    void* args[] = {&a};
    hipError_t e = hipLaunchCooperativeKernel((const void*)fwd_kernel, dim3(grid), dim3(512), args, LDS_BYTES, stream);
    if (e != hipSuccess) fprintf(stderr, "cooperative launch failed: %s (grid %d)\n", hipGetErrorString(e), grid);
}
```
